# Optimizing an MI355X kernel written in HIP

```python
import math
import jax
import jax.numpy as jnp
from jax import lax
import numpy as np

D_MODEL = 2048
BATCH = 4
SEQ = 2048
DEPTH = 4
DEC_BATCH = 8
DEC_SEQ = 4
PAST_LEN = 16384
PAGE_SIZE = 128

HEAD_DIM = 128
H_PER_GROUP = 8
ATT_GROUPS = ((128, 1), (512, 4), (2048, 16))
N_GROUPS = 3
N_ATT_HEADS = N_GROUPS * H_PER_GROUP
QKV_WIDTH = N_ATT_HEADS * HEAD_DIM
ATT_WIDTH = H_PER_GROUP * HEAD_DIM
N_BUCKETS = 32
REL_MAX_DIST = 2048
BLK = 128
LRU_WIDTH = D_MODEL
LRU_BLOCKS = 16
LRU_BLOCK = LRU_WIDTH // LRU_BLOCKS
CONV_WIDTH = 4
LRU_C = 8.0
IN_COLS = 3 * QKV_WIDTH + ATT_WIDTH + 2 * LRU_WIDTH + 2 * D_MODEL
RMS_EPS = 1e-6
NEG = -1e30

kernel_name = "hybrid_dilated_attn_rglru_decoder_step"


def _rmsnorm(x, g):
    xf = x.astype(jnp.float32)
    y = xf * lax.rsqrt(jnp.mean(xf * xf, axis=-1, keepdims=True) + RMS_EPS)
    return (y * g.astype(jnp.float32)).astype(x.dtype)


def _t5_bucket(dist):
    dist = np.asarray(dist).astype(np.int32)
    max_exact = N_BUCKETS // 2
    safe = np.maximum(dist, 1).astype(np.float32)
    large = max_exact + (np.log(safe / max_exact) / np.float32(math.log(REL_MAX_DIST / max_exact))
                         * (N_BUCKETS - max_exact)).astype(np.int32)
    large = np.minimum(large, N_BUCKETS - 1)
    return np.where(dist < max_exact, dist, large).astype(np.int32)


def _band_attn_prompt(q, k, v, tbl, window, dil):
    B, T, H, Dh = q.shape
    J = window // dil
    span = BLK * dil
    Tp = -(-T // span) * span
    NB = Tp // span

    def blocks(a):
        a = jnp.pad(a, ((0, 0), (0, Tp - T), (0, 0), (0, 0)))
        a = a.reshape(B, NB, BLK, dil, H, Dh)
        return a.transpose(0, 3, 4, 1, 2, 5)

    def with_prev(a):
        prev = jnp.pad(a, ((0, 0), (0, 0), (0, 0), (1, 0), (0, 0), (0, 0)))[:, :, :, :-1]
        return jnp.concatenate([prev, a], axis=4)

    qb = blocks(q)
    kk = with_prev(blocks(k))
    vv = with_prev(blocks(v))
    qi = np.arange(BLK)[:, None]
    ki = np.arange(2 * BLK)[None, :]
    du = qi + BLK - ki
    band = (du >= 0) & (du <= J)
    nb = np.arange(NB)[:, None, None]
    valid = band[None] & (nb * BLK + ki[None] - BLK >= 0)
    bias = tbl[_t5_bucket(np.clip(du, 0, None) * dil)]
    bias = jnp.transpose(bias, (2, 0, 1)).astype(jnp.float32)
    logits = jnp.einsum('brhnqe,brhnke->brhnqk', qb, kk,
                        preferred_element_type=jnp.float32) * (HEAD_DIM ** -0.5)
    logits = jnp.where(valid[None, None, None], logits + bias[None, None, :, None], NEG)
    m = logits.max(axis=-1)
    p = jnp.exp(logits - m[..., None])
    s = p.sum(axis=-1)
    acc = jnp.einsum('brhnqk,brhnke->brhnqe', p, vv.astype(jnp.float32))
    acc = acc.transpose(0, 3, 4, 1, 2, 5).reshape(B, Tp, H, Dh)[:, :T]
    m = m.transpose(0, 3, 4, 1, 2).reshape(B, Tp, H)[:, :T]
    s = s.transpose(0, 3, 4, 1, 2).reshape(B, Tp, H)[:, :T]
    return acc, m, s


def _dilated_attn_step(q, k, v, kv_buf, tbl, window, dil):
    S = q.shape[1]
    Wb = kv_buf.shape[1]
    J = window // dil
    ext = jnp.concatenate([kv_buf, jnp.stack([k, v], axis=2).astype(kv_buf.dtype)], axis=1)
    j = np.arange(J + 1)
    idx = Wb + np.arange(S)[:, None] - j[None, :] * dil
    valid = idx >= 0
    g = ext[:, np.clip(idx, 0, None)]
    bias = tbl[_t5_bucket(j * dil)].astype(jnp.float32)
    logits = jnp.einsum('bshe,bsjhe->bshj', q, g[:, :, :, 0],
                        preferred_element_type=jnp.float32) * (HEAD_DIM ** -0.5)
    logits = jnp.where(valid[None, :, None, :], logits + bias.T[None, None], NEG)
    m = logits.max(axis=-1)
    p = jnp.exp(logits - m[..., None])
    s = p.sum(axis=-1)
    acc = jnp.einsum('bshj,bsjhe->bshe', p, g[:, :, :, 1].astype(jnp.float32))
    return acc, m, s, ext[:, S:]


def _merge_groups(accs, ms, ss):
    acc = jnp.stack(accs)
    m = jnp.stack(ms)
    s = jnp.stack(ss)
    w = jnp.exp(m - m.max(axis=0, keepdims=True))
    return (w[..., None] * acc).sum(axis=0) / (w * s).sum(axis=0)[..., None]


def _causal_conv(xb, buf, w, b):
    T = xb.shape[1]
    xp = jnp.concatenate([buf.astype(xb.dtype), xb], axis=1)
    y = xp[:, 0:T] * w[0]
    for tap in range(1, CONV_WIDTH):
        y = y + xp[:, tap:tap + T] * w[tap]
    return y + b, xp[:, T:]


def _rglru(x, h0, w_r, b_r, w_i, b_i, lam):
    B, T, C = x.shape
    xf = x.astype(jnp.float32)
    xblk = xf.reshape(B, T, LRU_BLOCKS, LRU_BLOCK)
    r = jax.nn.sigmoid(jnp.einsum('btnc,ncd->btnd', xblk, w_r.astype(jnp.float32)).reshape(B, T, C) + b_r)
    i = jax.nn.sigmoid(jnp.einsum('btnc,ncd->btnd', xblk, w_i.astype(jnp.float32)).reshape(B, T, C) + b_i)
    log_a = -LRU_C * r * jax.nn.softplus(-lam.astype(jnp.float32))
    a = jnp.exp(log_a)
    u = jnp.sqrt(-jnp.expm1(2.0 * log_a)) * (i * xf)
    u = u.at[:, 0].add(a[:, 0] * h0.astype(jnp.float32))

    def comb(l, rr):
        return (l[0] * rr[0], rr[0] * l[1] + rr[1])

    _, h = lax.associative_scan(comb, (a, u), axis=1)
    return h, h[:, -1]


def _layer(x, c, kv_bufs, conv_buf, h0, rel_bias, w_ada, b_ada, norm_g, w_in, conv_w, conv_b,
           w_r, b_r, w_i, b_i, lam, w_pa, w_pb, w_out):
    B, T, _ = x.shape
    mod = jnp.einsum('bd,de->be', jax.nn.silu(c), w_ada) + b_ada
    shift, scale, gate = jnp.split(mod, 3, axis=-1)
    h = _rmsnorm(x, norm_g) * (1 + scale[:, None]) + shift[:, None]
    proj = jnp.einsum('btd,de->bte', h, w_in)
    cuts = np.cumsum([QKV_WIDTH, QKV_WIDTH, QKV_WIDTH, ATT_WIDTH, LRU_WIDTH, LRU_WIDTH, D_MODEL]).tolist()
    q, k, v, z_att, x_lru, z_lru, g_att, g_lru = jnp.split(proj, cuts, axis=-1)
    heads = (B, T, N_GROUPS, H_PER_GROUP, HEAD_DIM)
    q, k, v = q.reshape(heads), k.reshape(heads), v.reshape(heads)
    accs, ms, ss, new_kv = [], [], [], []
    for gi, (win, dil) in enumerate(ATT_GROUPS):
        tbl = rel_bias[:, gi * H_PER_GROUP:(gi + 1) * H_PER_GROUP]
        qg, kg, vg = q[:, :, gi], k[:, :, gi], v[:, :, gi]
        if kv_bufs is None:
            acc, m, s = _band_attn_prompt(qg, kg, vg, tbl, win, dil)
            new = jnp.stack([kg, vg], axis=2)[:, T - min(win, T):]
        else:
            acc, m, s, new = _dilated_attn_step(qg, kg, vg, kv_bufs[gi], tbl, win, dil)
        accs.append(acc)
        ms.append(m)
        ss.append(s)
        new_kv.append(new)
    att = _merge_groups(accs, ms, ss).reshape(B, T, ATT_WIDTH).astype(x.dtype)
    y_att = jnp.einsum('bte,ed->btd', att * jax.nn.silu(z_att), w_pa)
    if conv_buf is None:
        conv_buf = jnp.zeros((B, CONV_WIDTH - 1, LRU_WIDTH), x.dtype)
        h0 = jnp.zeros((B, LRU_WIDTH), jnp.float32)
    xc, new_conv = _causal_conv(x_lru, conv_buf, conv_w, conv_b)
    hs, h_last = _rglru(xc, h0, w_r, b_r, w_i, b_i, lam)
    y_lru = jnp.einsum('bte,ed->btd', hs.astype(x.dtype) * jax.nn.silu(z_lru), w_pb)
    merged = jax.nn.sigmoid(g_att) * y_att + jax.nn.sigmoid(g_lru) * y_lru
    out = jnp.einsum('btd,de->bte', merged, w_out)
    return x + gate[:, None] * out, new_kv, new_conv, h_last


def setup_inputs(seed: int = 0) -> dict:
    key = jax.random.key(seed)
    ks = jax.random.split(key, 26)
    f32 = jnp.float32

    def nrm(k, shape, s):
        return jax.random.normal(k, shape, f32) * s

    (w0, _), (w1, _), (w2, _) = ATT_GROUPS
    u = jax.random.uniform(ks[20], (DEPTH, LRU_WIDTH), f32, 0.9, 0.999)
    sig = u ** (1.0 / LRU_C)
    lam = jnp.log(sig) - jnp.log1p(-sig)
    return {
        'x_prompt': nrm(ks[0], (BATCH, SEQ, D_MODEL), 1.0),
        'x_sample': nrm(ks[1], (DEC_BATCH, DEC_SEQ, D_MODEL), 1.0),
        'c_prompt': nrm(ks[2], (BATCH, D_MODEL), 1.0),
        'c_sample': nrm(ks[3], (DEC_BATCH, D_MODEL), 1.0),
        'cache_kv_g0': nrm(ks[4], (DEPTH, DEC_BATCH, min(w0, PAST_LEN), 2, H_PER_GROUP, HEAD_DIM), 1.0),
        'cache_kv_g1': nrm(ks[5], (DEPTH, DEC_BATCH, min(w1, PAST_LEN), 2, H_PER_GROUP, HEAD_DIM), 1.0),
        'cache_kv_g2': nrm(ks[6], (DEPTH, DEC_BATCH, min(w2, PAST_LEN), 2, H_PER_GROUP, HEAD_DIM), 1.0),
        'state_conv': nrm(ks[7], (DEPTH, DEC_BATCH, CONV_WIDTH - 1, LRU_WIDTH), 1.0),
        'state_h': nrm(ks[8], (DEPTH, DEC_BATCH, LRU_WIDTH), 0.5),
        'rel_bias': nrm(ks[9], (N_BUCKETS, N_ATT_HEADS), 0.3),
        'w_ada': nrm(ks[10], (DEPTH, D_MODEL, 3 * D_MODEL), 0.5 * D_MODEL ** -0.5),
        'b_ada': nrm(ks[11], (DEPTH, 3 * D_MODEL), 0.02),
        'norm_g': 1.0 + nrm(ks[12], (DEPTH, D_MODEL), 0.02),
        'w_in': nrm(ks[13], (DEPTH, D_MODEL, IN_COLS), D_MODEL ** -0.5),
        'conv_w': nrm(ks[14], (DEPTH, CONV_WIDTH, LRU_WIDTH), CONV_WIDTH ** -0.5),
        'conv_b': nrm(ks[15], (DEPTH, LRU_WIDTH), 0.02),
        'w_r': nrm(ks[16], (DEPTH, LRU_BLOCKS, LRU_BLOCK, LRU_BLOCK), LRU_BLOCK ** -0.5),
        'b_r': nrm(ks[17], (DEPTH, LRU_WIDTH), 0.1),
        'w_i': nrm(ks[18], (DEPTH, LRU_BLOCKS, LRU_BLOCK, LRU_BLOCK), LRU_BLOCK ** -0.5),
        'b_i': nrm(ks[19], (DEPTH, LRU_WIDTH), 0.1),
        'lam': lam,
        'w_pa': nrm(ks[21], (DEPTH, ATT_WIDTH, D_MODEL), ATT_WIDTH ** -0.5),
        'w_pb': nrm(ks[22], (DEPTH, LRU_WIDTH, D_MODEL), LRU_WIDTH ** -0.5),
        'w_out': nrm(ks[23], (DEPTH, D_MODEL, D_MODEL), D_MODEL ** -0.5),
        'final_g': 1.0 + nrm(ks[24], (D_MODEL,), 0.02),
    }


def reference(x_prompt, x_sample, c_prompt, c_sample, cache_kv_g0, cache_kv_g1, cache_kv_g2,
              state_conv, state_h, rel_bias, w_ada, b_ada, norm_g, w_in, conv_w, conv_b,
              w_r, b_r, w_i, b_i, lam, w_pa, w_pb, w_out, final_g):
    kv_p = ([], [], [])
    kv_s = ([], [], [])
    conv_p, conv_s, h_p, h_s = [], [], [], []
    xp, xs = x_prompt, x_sample
    for l in range(DEPTH):
        lw = (w_ada[l], b_ada[l], norm_g[l], w_in[l], conv_w[l], conv_b[l], w_r[l], b_r[l],
              w_i[l], b_i[l], lam[l], w_pa[l], w_pb[l], w_out[l])
        xp, kv, cv, hl = _layer(xp, c_prompt, None, None, None, rel_bias, *lw)
        for gi in range(N_GROUPS):
            kv_p[gi].append(kv[gi])
        conv_p.append(cv)
        h_p.append(hl)
        xs, kv, cv, hl = _layer(xs, c_sample, (cache_kv_g0[l], cache_kv_g1[l], cache_kv_g2[l]),
                                state_conv[l], state_h[l], rel_bias, *lw)
        for gi in range(N_GROUPS):
            kv_s[gi].append(kv[gi])
        conv_s.append(cv)
        h_s.append(hl)
    y_prompt = _rmsnorm(xp, final_g)
    y_sample = _rmsnorm(xs, final_g)
    kv_g0_prompt = jnp.stack(kv_p[0])
    kv_g1_prompt = jnp.stack(kv_p[1])
    kv_g2_prompt = jnp.stack(kv_p[2])
    conv_prompt = jnp.stack(conv_p)
    h_prompt = jnp.stack(h_p)
    kv_g0_sample = jnp.stack(kv_s[0])
    kv_g1_sample = jnp.stack(kv_s[1])
    kv_g2_sample = jnp.stack(kv_s[2])
    conv_sample = jnp.stack(conv_s)
    h_sample = jnp.stack(h_s)
    return (y_prompt, y_sample, kv_g0_prompt, kv_g1_prompt, kv_g2_prompt, conv_prompt, h_prompt,
            kv_g0_sample, kv_g1_sample, kv_g2_sample, conv_sample, h_sample)
```

```cpp
#include <hip/hip_runtime.h>
#include <cstdio>
#include <cstdint>
namespace pg8 {
#define PG8_LAS __attribute__((address_space(3)))
typedef unsigned short bf16_t;
typedef short bf16x8 __attribute__((ext_vector_type(8)));
typedef float f32x4 __attribute__((ext_vector_type(4)));
typedef unsigned u32x4 __attribute__((ext_vector_type(4)));
constexpr int BM = 256, BK = 64, HALF = 128, HTB = HALF * BK * 2  , STAGE_BYTES = 8 * HTB, NXCD = 8, WGM = 8;

__host__ __device__ __forceinline__ int lds_byte(int r, int c) { const int st = (r >> 4) * 2 + (c >> 5), rr = r & 15, cc = c & 31, ob = rr * 64 + cc * 2; return st * 1024 + (ob ^ (((ob >> 9) & 1) << 5)); }
__host__ __device__ __forceinline__ void stage_rc(int b, int& R, int& C) { const int st = b / 1024, sb = b % 1024, swz = sb ^ (((sb >> 9) & 1) << 5); R = (st >> 1) * 16 + swz / 64; C = (st & 1) * 32 + (swz % 64) / 2; }
__host__ __device__ __forceinline__ int perm32(int rho) { const int n = rho >> 4, i = rho & 15; return 8 * (i >> 2) + 4 * n + (i & 3); }

struct Unit { int pm, pn; };
struct Gemm { const bf16_t* A; const bf16_t* Bt; int M, N, K; };

struct StaticOrder {
    int nM, nN, nwg, G, c;
    __host__ __device__ void init(int M, int N, int G_, int c_) { nM = M / BM; nN = N / BM; nwg = nM * nN; G = G_; c = c_; }
    __host__ __device__ bool next(int i, Unit& u) const {
        const long L = (long)i * G + c; if (L >= nwg) return false;
        int wgid = (int)L; { const int q = nwg / NXCD, r = nwg % NXCD, xcd = wgid % NXCD, off = wgid / NXCD; wgid = (xcd < r ? xcd * (q + 1) : r * (q + 1) + (xcd - r) * q) + off; }
        const int nig = WGM * nN, gid = wgid / nig, fm = gid * WGM, gsz = (nM - fm) < WGM ? (nM - fm) : WGM;
        u.pm = fm + ((wgid % nig) % gsz); u.pn = (wgid % nig) / gsz; return true;
    }
    __device__ __forceinline__ void a_ready(const Unit&) const {}
    __device__ __forceinline__ void done(const Unit&) const {}
};

__device__ __forceinline__ unsigned cvt_pk_bf16(float lo, float hi) { unsigned r; asm volatile("v_cvt_pk_bf16_f32 %0, %1, %2" : "=v"(r) : "v"(lo), "v"(hi)); return r; }
typedef float f32x2 __attribute__((ext_vector_type(2)));
template <class Epi, class Sched, bool ALIGN_EPI = false, bool SP2 = false>
__device__ __forceinline__ void gemm_phase(PG8_LAS unsigned char* lds, const Gemm g, const Sched& S, const Epi& E, int tid_in) {
    int tid_ = tid_in; asm volatile("" : "+v"(tid_));
    const int tid = tid_, wid = __builtin_amdgcn_readfirstlane(tid >> 6), lane = tid & 63, wr = wid >> 2, wc = wid & 3, fr = lane & 15, fq = lane >> 4;
    const int K = g.K, nt = K / BK;
    unsigned voffA[2], voffB[2];
#pragma unroll
    for (int i = 0; i < 2; ++i) { int R, C; stage_rc(tid * 16 + i * 8192, R, C); const int Rb = Epi::PERM ? ((R & ~31) + perm32(R & 31)) : R;
        voffA[i] = (unsigned)(R * K + C) * 2u; voffB[i] = (unsigned)(Rb * K + C) * 2u; }
    const size_t kstep = (size_t)(BK * 2);
    const size_t hstep = (size_t)HALF * K * 2;
    const size_t tstep = 2 * hstep;
    const unsigned ldsw = (unsigned)wid * 1024u;
    const int aoff = lds_byte(wr * 64 + fr, fq * 8), boff = lds_byte(wc * 32 + fr, fq * 8);
#define PG8_SA(b, h) (((b) * 2 + (h)) * HTB)
#define PG8_SB(b, h) ((4 + (b) * 2 + (h)) * HTB)
#define PG8_STAGE(bufoff, gbase, voff) do { _Pragma("unroll") for (int _i = 0; _i < 2; ++_i) \
        __builtin_amdgcn_global_load_lds((const unsigned*)((const char*)(gbase) + (voff)[_i]), (PG8_LAS unsigned*)(lds + (bufoff) + ldsw + _i * 8192), 16, 0, 0); } while (0)
#define PG8_LDA(dst, b, h) do { _Pragma("unroll") for (int m = 0; m < 4; ++m) _Pragma("unroll") for (int k = 0; k < 2; ++k) dst[m][k] = *(const PG8_LAS bf16x8*)(lds + PG8_SA(b, h) + aoff + m * 2048 + k * 1024); } while (0)
#define PG8_LDB(dst, b, h) do { _Pragma("unroll") for (int n = 0; n < 2; ++n) _Pragma("unroll") for (int k = 0; k < 2; ++k) dst[n][k] = *(const PG8_LAS bf16x8*)(lds + PG8_SB(b, h) + boff + n * 2048 + k * 1024); } while (0)
#define PG8_MMA(ai, bj, At, Bt) do { __builtin_amdgcn_s_setprio(1); _Pragma("unroll") for (int m = 0; m < 4; ++m) _Pragma("unroll") for (int n = 0; n < 2; ++n) _Pragma("unroll") for (int k = 0; k < 2; ++k) \
        acc[ai][bj][m][n] = __builtin_amdgcn_mfma_f32_16x16x32_bf16(Bt[n][k], At[m][k], acc[ai][bj][m][n], 0, 0, 0); __builtin_amdgcn_s_setprio(0); } while (0)
#define PG8_WAIT_V(n) asm volatile("s_waitcnt vmcnt(" #n ")" ::: "memory")
#define PG8_WAIT_L(n) asm volatile("s_waitcnt lgkmcnt(" #n ")" ::: "memory")
#define PG8_BAR __builtin_amdgcn_s_barrier()
#define PG8_SCHED __builtin_amdgcn_sched_barrier(0)
    Unit cur, nxt; int ui = 0;
    if (!S.next(0, cur)) return;
    f32x4 acc[2][2][4][2];
#pragma unroll
    for (int a = 0; a < 2; ++a)
#pragma unroll
        for (int b = 0; b < 2; ++b)
#pragma unroll
            for (int m = 0; m < 4; ++m)
#pragma unroll
                for (int n = 0; n < 2; ++n) acc[a][b][m][n] = (f32x4){0.f, 0.f, 0.f, 0.f};
    bf16x8 At[4][2], B0[2][2], B1[2][2];
    const char* cA = (const char*)g.A + (size_t)cur.pm * tstep; const char* cB = (const char*)g.Bt + (size_t)cur.pn * tstep;
    S.a_ready(cur);
    if constexpr (SP2) {
        PG8_STAGE(PG8_SB(0, 0), cB, voffB); PG8_STAGE(PG8_SB(0, 1), cB + hstep, voffB); PG8_STAGE(PG8_SA(0, 0), cA, voffA); PG8_STAGE(PG8_SA(0, 1), cA + hstep, voffA);
        if (wr == 1) PG8_BAR;
        PG8_WAIT_V(2); PG8_BAR;
        PG8_STAGE(PG8_SB(1, 0), cB + kstep, voffB); PG8_STAGE(PG8_SA(1, 0), cA + kstep, voffA); PG8_STAGE(PG8_SB(1, 1), cB + hstep + kstep, voffB);
        PG8_WAIT_V(6); PG8_BAR;
    } else {
        PG8_STAGE(PG8_SB(0, 0), cB, voffB); PG8_STAGE(PG8_SA(0, 0), cA, voffA); PG8_STAGE(PG8_SB(0, 1), cB + hstep, voffB); PG8_STAGE(PG8_SA(0, 1), cA + hstep, voffA);
        if (wr == 1) PG8_BAR;
        PG8_WAIT_V(4); PG8_BAR;
        PG8_STAGE(PG8_SB(1, 0), cB + kstep, voffB); PG8_STAGE(PG8_SA(1, 0), cA + kstep, voffA); PG8_STAGE(PG8_SB(1, 1), cB + hstep + kstep, voffB);
        PG8_WAIT_V(6); PG8_BAR;
    }
    for (;;) {
        const bool has_next = S.next(ui + 1, nxt);
        const char* nA = has_next ? (const char*)g.A + (size_t)nxt.pm * tstep : cA; const char* nB = has_next ? (const char*)g.Bt + (size_t)nxt.pn * tstep : cB;
        for (int t = 0; t < nt; t += 2) {
            const bool last = (t == nt - 2);
            const char* a1 = cA + (size_t)(t + 1) * kstep;
            const char* a2 = last ? nA : cA + (size_t)(t + 2) * kstep; const char* b2 = last ? nB : cB + (size_t)(t + 2) * kstep;
            const char* a3 = a2 + kstep; const char* b3 = b2 + kstep;
            if (last && has_next) S.a_ready(nxt);
            if constexpr (SP2) {
            PG8_LDB(B0, 0, 0); PG8_LDB(B1, 0, 1); PG8_SCHED; PG8_LDA(At, 0, 0); PG8_STAGE(PG8_SA(1, 1), a1 + hstep, voffA);
            PG8_WAIT_V(8); PG8_WAIT_L(0); PG8_BAR; PG8_MMA(0, 0, At, B0); PG8_MMA(0, 1, At, B1); PG8_BAR; PG8_SCHED;
            PG8_LDA(At, 0, 1); PG8_STAGE(PG8_SB(0, 0), b2, voffB); PG8_STAGE(PG8_SB(0, 1), b2 + hstep, voffB); PG8_STAGE(PG8_SA(0, 0), a2, voffA);
            PG8_WAIT_V(8); PG8_WAIT_L(0); PG8_BAR; PG8_MMA(1, 0, At, B0); PG8_MMA(1, 1, At, B1); PG8_BAR; PG8_SCHED;
            PG8_LDB(B0, 1, 0); PG8_LDB(B1, 1, 1); PG8_SCHED; PG8_LDA(At, 1, 0); PG8_STAGE(PG8_SA(0, 1), a2 + hstep, voffA);
            PG8_WAIT_V(8); PG8_WAIT_L(0); PG8_BAR; PG8_MMA(0, 0, At, B0); PG8_MMA(0, 1, At, B1); PG8_BAR; PG8_SCHED;
            PG8_LDA(At, 1, 1); PG8_STAGE(PG8_SB(1, 0), b3, voffB); PG8_STAGE(PG8_SB(1, 1), b3 + hstep, voffB); PG8_STAGE(PG8_SA(1, 0), a3, voffA);
            PG8_WAIT_V(8); PG8_WAIT_L(0); PG8_BAR; PG8_MMA(1, 0, At, B0); PG8_MMA(1, 1, At, B1); PG8_BAR; PG8_SCHED;
            } else {
            PG8_LDB(B0, 0, 0); PG8_SCHED; PG8_LDA(At, 0, 0); PG8_STAGE(PG8_SA(1, 1), a1 + hstep, voffA);
            PG8_WAIT_L(8); PG8_BAR; PG8_WAIT_L(0); PG8_MMA(0, 0, At, B0); PG8_BAR; PG8_SCHED;
            PG8_LDB(B1, 0, 1); PG8_STAGE(PG8_SB(0, 0), b2, voffB);
            PG8_BAR; PG8_WAIT_L(0); PG8_MMA(0, 1, At, B1); PG8_BAR;
            PG8_LDA(At, 0, 1); PG8_STAGE(PG8_SA(0, 0), a2, voffA);
            PG8_BAR; PG8_WAIT_L(0); PG8_MMA(1, 0, At, B0); PG8_BAR; PG8_SCHED;
            PG8_STAGE(PG8_SB(0, 1), b2 + hstep, voffB);
            PG8_WAIT_V(6); PG8_BAR; PG8_MMA(1, 1, At, B1); PG8_BAR;
            PG8_LDB(B0, 1, 0); PG8_SCHED; PG8_LDA(At, 1, 0); PG8_STAGE(PG8_SA(0, 1), a2 + hstep, voffA);
            PG8_WAIT_L(8); PG8_BAR; PG8_WAIT_L(0); PG8_MMA(0, 0, At, B0); PG8_BAR; PG8_SCHED;
            PG8_LDB(B1, 1, 1); PG8_STAGE(PG8_SB(1, 0), b3, voffB);
            PG8_BAR; PG8_WAIT_L(0); PG8_MMA(0, 1, At, B1); PG8_BAR;
            PG8_LDA(At, 1, 1); PG8_STAGE(PG8_SA(1, 0), a3, voffA);
            PG8_BAR; PG8_WAIT_L(0); PG8_MMA(1, 0, At, B0); PG8_BAR; PG8_SCHED;
            PG8_STAGE(PG8_SB(1, 1), b3 + hstep, voffB);
            PG8_WAIT_V(6); PG8_BAR; PG8_MMA(1, 1, At, B1); PG8_BAR;
            }
        }
        if constexpr (ALIGN_EPI) { if (wr == 0) PG8_BAR; }
        if constexpr (!Epi::AFTER_DRAIN) { E(acc, cur, wr, wc, fr, fq); S.done(cur); }
        if (!has_next) break;
#pragma unroll
        for (int a = 0; a < 2; ++a)
#pragma unroll
            for (int b = 0; b < 2; ++b)
#pragma unroll
                for (int m = 0; m < 4; ++m)
#pragma unroll
                    for (int n = 0; n < 2; ++n) acc[a][b][m][n] = (f32x4){0.f, 0.f, 0.f, 0.f};
        cur = nxt; cA = nA; cB = nB; ++ui;
        if constexpr (ALIGN_EPI) { if (wr == 1) PG8_BAR; }
    }
    PG8_WAIT_V(0);
    if constexpr (!ALIGN_EPI) { if (wr == 0) PG8_BAR; }
    PG8_BAR;
    if constexpr (Epi::AFTER_DRAIN) { E.fused(acc, cur, wr, wc, fr, fq, lds, wid, lane); S.done(cur); }
#undef PG8_SA
#undef PG8_SB
#undef PG8_STAGE
#undef PG8_LDA
#undef PG8_LDB
#undef PG8_MMA
#undef PG8_WAIT_V
#undef PG8_WAIT_L
#undef PG8_BAR
#undef PG8_SCHED
}
template <class Epi, class Sched>
__device__ __forceinline__ void gemm_chain(PG8_LAS unsigned char* lds, const Gemm g0, const Gemm g1, int ld, const Sched& S, const Epi& E, int tid_in) {
    int tid_ = tid_in; asm volatile("" : "+v"(tid_));
    const int tid = tid_, wid = __builtin_amdgcn_readfirstlane(tid >> 6), lane = tid & 63, wr = wid >> 2, wc = wid & 3, fr = lane & 15, fq = lane >> 4;
    const int K0 = g0.K, K1 = g1.K;
    unsigned voffA[2], voffB[2];
#pragma unroll
    for (int i = 0; i < 2; ++i) { int R, C; stage_rc(tid * 16 + i * 8192, R, C); const int Rb = Epi::PERM ? ((R & ~31) + perm32(R & 31)) : R;
        voffA[i] = (unsigned)(R * ld + C) * 2u; voffB[i] = (unsigned)(Rb * ld + C) * 2u; }
    const size_t kstep = (size_t)(BK * 2);
    const size_t hstep = (size_t)HALF * ld * 2, tstep = 2 * hstep;
    const unsigned ldsw = (unsigned)wid * 1024u;
    const int aoff = lds_byte(wr * 64 + fr, fq * 8), boff = lds_byte(wc * 32 + fr, fq * 8);
#define PG8_SA(b, h) (((b) * 2 + (h)) * HTB)
#define PG8_SB(b, h) ((4 + (b) * 2 + (h)) * HTB)
#define PG8_STAGE(bufoff, gbase, voff) do { _Pragma("unroll") for (int _i = 0; _i < 2; ++_i) \
        __builtin_amdgcn_global_load_lds((const unsigned*)((const char*)(gbase) + (voff)[_i]), (PG8_LAS unsigned*)(lds + (bufoff) + ldsw + _i * 8192), 16, 0, 0); } while (0)
#define PG8_LDA(dst, b, h) do { _Pragma("unroll") for (int m = 0; m < 4; ++m) _Pragma("unroll") for (int k = 0; k < 2; ++k) dst[m][k] = *(const PG8_LAS bf16x8*)(lds + PG8_SA(b, h) + aoff + m * 2048 + k * 1024); } while (0)
#define PG8_LDB(dst, b, h) do { _Pragma("unroll") for (int n = 0; n < 2; ++n) _Pragma("unroll") for (int k = 0; k < 2; ++k) dst[n][k] = *(const PG8_LAS bf16x8*)(lds + PG8_SB(b, h) + boff + n * 2048 + k * 1024); } while (0)
#define PG8_MMA(ai, bj, At, Bt) do { __builtin_amdgcn_s_setprio(1); _Pragma("unroll") for (int m = 0; m < 4; ++m) _Pragma("unroll") for (int n = 0; n < 2; ++n) _Pragma("unroll") for (int k = 0; k < 2; ++k) \
        acc[ai][bj][m][n] = __builtin_amdgcn_mfma_f32_16x16x32_bf16(Bt[n][k], At[m][k], acc[ai][bj][m][n], 0, 0, 0); __builtin_amdgcn_s_setprio(0); } while (0)
#define PG8_WAIT_V(n) asm volatile("s_waitcnt vmcnt(" #n ")" ::: "memory")
#define PG8_WAIT_L(n) asm volatile("s_waitcnt lgkmcnt(" #n ")" ::: "memory")
#define PG8_BAR __builtin_amdgcn_s_barrier()
#define PG8_SCHED __builtin_amdgcn_sched_barrier(0)
    Unit cur, nxt; int ui = 0;
    if (!S.next(0, cur)) return;
    f32x4 acc[2][2][4][2];
#pragma unroll
    for (int a = 0; a < 2; ++a)
#pragma unroll
        for (int b = 0; b < 2; ++b)
#pragma unroll
            for (int m = 0; m < 4; ++m)
#pragma unroll
                for (int n = 0; n < 2; ++n) acc[a][b][m][n] = (f32x4){0.f, 0.f, 0.f, 0.f};
    bf16x8 At[4][2], B0[2][2], B1[2][2];
    const char* cA = (const char*)g0.A + (size_t)cur.pm * tstep; const char* cB = (const char*)g0.Bt + (size_t)cur.pn * tstep;
    PG8_STAGE(PG8_SB(0, 0), cB, voffB); PG8_STAGE(PG8_SB(0, 1), cB + hstep, voffB); PG8_STAGE(PG8_SA(0, 0), cA, voffA); PG8_STAGE(PG8_SA(0, 1), cA + hstep, voffA);
    if (wr == 1) PG8_BAR;
    PG8_WAIT_V(2); PG8_BAR;
    PG8_STAGE(PG8_SB(1, 0), cB + kstep, voffB); PG8_STAGE(PG8_SA(1, 0), cA + kstep, voffA); PG8_STAGE(PG8_SB(1, 1), cB + hstep + kstep, voffB);
    PG8_WAIT_V(6); PG8_BAR;
#define PG8_KSTREAM(NT_, CA_, CB_, NA_, NB_) do { const int nt_ = (NT_); \
        for (int t = 0; t < nt_; t += 2) { \
            const bool last = (t == nt_ - 2); \
            const char* a1 = (CA_) + (size_t)(t + 1) * kstep; \
            const char* a2 = last ? (NA_) : (CA_) + (size_t)(t + 2) * kstep; const char* b2 = last ? (NB_) : (CB_) + (size_t)(t + 2) * kstep; \
            const char* a3 = a2 + kstep; const char* b3 = b2 + kstep; \
            PG8_LDB(B0, 0, 0); PG8_LDB(B1, 0, 1); PG8_SCHED; PG8_LDA(At, 0, 0); PG8_STAGE(PG8_SA(1, 1), a1 + hstep, voffA); \
            PG8_WAIT_V(8); PG8_WAIT_L(0); PG8_BAR; PG8_MMA(0, 0, At, B0); PG8_MMA(0, 1, At, B1); PG8_BAR; PG8_SCHED; \
            PG8_LDA(At, 0, 1); PG8_STAGE(PG8_SB(0, 0), b2, voffB); PG8_STAGE(PG8_SB(0, 1), b2 + hstep, voffB); PG8_STAGE(PG8_SA(0, 0), a2, voffA); \
            PG8_WAIT_V(8); PG8_WAIT_L(0); PG8_BAR; PG8_MMA(1, 0, At, B0); PG8_MMA(1, 1, At, B1); PG8_BAR; PG8_SCHED; \
            PG8_LDB(B0, 1, 0); PG8_LDB(B1, 1, 1); PG8_SCHED; PG8_LDA(At, 1, 0); PG8_STAGE(PG8_SA(0, 1), a2 + hstep, voffA); \
            PG8_WAIT_V(8); PG8_WAIT_L(0); PG8_BAR; PG8_MMA(0, 0, At, B0); PG8_MMA(0, 1, At, B1); PG8_BAR; PG8_SCHED; \
            PG8_LDA(At, 1, 1); PG8_STAGE(PG8_SB(1, 0), b3, voffB); PG8_STAGE(PG8_SB(1, 1), b3 + hstep, voffB); PG8_STAGE(PG8_SA(1, 0), a3, voffA); \
            PG8_WAIT_V(8); PG8_WAIT_L(0); PG8_BAR; PG8_MMA(1, 0, At, B0); PG8_MMA(1, 1, At, B1); PG8_BAR; PG8_SCHED; \
        } } while (0)
    for (;;) {
        const char* mA = (const char*)g1.A + (size_t)cur.pm * tstep; const char* mB = (const char*)g1.Bt + (size_t)cur.pn * tstep;
        PG8_KSTREAM(K0 / BK, cA, cB, mA, mB);
        E.mid(acc, cur, wr, wc, fr, fq);
        const bool has_tile = S.next(ui + 1, nxt);
        const char* nA = has_tile ? (const char*)g0.A + (size_t)nxt.pm * tstep : mA; const char* nB = has_tile ? (const char*)g0.Bt + (size_t)nxt.pn * tstep : mB;
        PG8_KSTREAM(K1 / BK, mA, mB, nA, nB);
        E(acc, cur, wr, wc, fr, fq);
        if (!has_tile) break;
#pragma unroll
        for (int a = 0; a < 2; ++a)
#pragma unroll
            for (int b = 0; b < 2; ++b)
#pragma unroll
                for (int m = 0; m < 4; ++m)
#pragma unroll
                    for (int n = 0; n < 2; ++n) acc[a][b][m][n] = (f32x4){0.f, 0.f, 0.f, 0.f};
        cur = nxt; cA = nA; cB = nB; ++ui;
    }
#undef PG8_KSTREAM
    PG8_WAIT_V(0);
    if (wr == 0) PG8_BAR;
    PG8_BAR;
#undef PG8_SA
#undef PG8_SB
#undef PG8_STAGE
#undef PG8_LDA
#undef PG8_LDB
#undef PG8_MMA
#undef PG8_WAIT_V
#undef PG8_WAIT_L
#undef PG8_BAR
#undef PG8_SCHED
}
}

#define GAS __attribute__((address_space(1)))
#define LAS __attribute__((address_space(3)))
typedef unsigned short bf16;
typedef unsigned u32x4 __attribute__((ext_vector_type(4)));
typedef unsigned u32x2 __attribute__((ext_vector_type(2)));
typedef float f32x4 __attribute__((ext_vector_type(4)));
typedef short bf16x8 __attribute__((ext_vector_type(8)));
typedef short s16x4 __attribute__((ext_vector_type(4)));

constexpr int DM = 2048, NB_P = 4, TT = 2048, DEPTH = 4, NB_S = 8, TS = 4;
constexpr int MP = NB_P * TT;
constexpr int MS = NB_S * TS;
constexpr int MR = MP + MS;
constexpr int MPAD = 8448;
constexpr int QKVW = 3072, ATTW = 1024, INC = 18432;
constexpr int C_K = 3072, C_V = 6144, C_ZA = 9216, C_XL = 10240, C_ZL = 12288, C_GA = 14336, C_GL = 16384;
constexpr int NMODB = 12;
constexpr float RMS_EPS = 1e-6f;
constexpr float LOG2E = 1.4426950408889634f;
constexpr float QSCALE = 0.08838834764831845f * 1.4426950408889634f;

constexpr size_t KVROW = 2048;
constexpr size_t O_YP = 0;
constexpr size_t O_YS = O_YP + (size_t)MP * DM;
constexpr size_t O_KVP0 = O_YS + (size_t)MS * DM;
constexpr size_t O_KVP1 = O_KVP0 + (size_t)DEPTH * NB_P * 128 * KVROW;
constexpr size_t O_KVP2 = O_KVP1 + (size_t)DEPTH * NB_P * 512 * KVROW;
constexpr size_t O_CVP = O_KVP2 + (size_t)DEPTH * NB_P * 2048 * KVROW;
constexpr size_t O_HP = O_CVP + (size_t)DEPTH * NB_P * 3 * DM;
constexpr size_t O_KVS0 = O_HP + (size_t)DEPTH * NB_P * DM;
constexpr size_t O_KVS1 = O_KVS0 + (size_t)DEPTH * NB_S * 128 * KVROW;
constexpr size_t O_KVS2 = O_KVS1 + (size_t)DEPTH * NB_S * 512 * KVROW;
constexpr size_t O_CVS = O_KVS2 + (size_t)DEPTH * NB_S * 2048 * KVROW;
constexpr size_t O_HS = O_CVS + (size_t)DEPTH * NB_S * 3 * DM;
constexpr size_t O_END = O_HS + (size_t)DEPTH * NB_S * DM;
static_assert(O_END == 281477120ull, "d_out size");

constexpr size_t MiB = 1u << 20;
constexpr size_t al1(size_t x) { return (x + MiB - 1) / MiB * MiB; }
constexpr size_t WS_CTL = 0, CTL_ZERO_BYTES = 1 * MiB;
constexpr size_t WS_WIN = 1 * MiB;
constexpr size_t WS_WPA = WS_WIN + al1((size_t)DEPTH * INC * DM * 2);
constexpr size_t WS_WPB = WS_WPA + al1((size_t)DEPTH * DM * DM * 2);
constexpr size_t WS_WOUT = WS_WPB + al1((size_t)DEPTH * DM * DM * 2);
constexpr size_t WS_WR = WS_WOUT + al1((size_t)DEPTH * DM * DM * 2);
constexpr size_t WS_WI = WS_WR + al1((size_t)DEPTH * 16 * 128 * 128 * 2);
constexpr size_t WS_MODP = WS_WI + al1((size_t)DEPTH * 16 * 128 * 128 * 2);
constexpr size_t WS_MOD = WS_MODP + al1((size_t)DEPTH * 16 * NMODB * 6144 * 4);
constexpr size_t WS_H = WS_MOD + al1((size_t)DEPTH * NMODB * 6144 * 4);
constexpr size_t WS_Q = WS_H + al1((size_t)MPAD * DM * 2);
constexpr size_t WS_K = WS_Q + al1((size_t)MPAD * QKVW * 2);
constexpr size_t WS_V = WS_K + al1((size_t)MPAD * QKVW * 2);
constexpr size_t WS_ZA = WS_V + al1((size_t)MPAD * QKVW * 2);
constexpr size_t WS_XL = WS_ZA + al1((size_t)MPAD * ATTW * 2);
constexpr size_t WS_ZL = WS_XL + al1((size_t)MPAD * DM * 2);
constexpr size_t WS_GA = WS_ZL + al1((size_t)MPAD * DM * 2);
constexpr size_t WS_GL = WS_GA + al1((size_t)MPAD * DM * 2);
constexpr size_t WS_OG = WS_GL + al1((size_t)MPAD * DM * 2);
constexpr size_t WS_LSE = WS_OG + al1((size_t)3 * MPAD * ATTW * 2);
constexpr size_t WS_AA = WS_LSE + al1((size_t)3 * MPAD * 8 * 4);
constexpr size_t WS_AL = WS_AA + al1((size_t)MPAD * DM * 2);
constexpr size_t WS_TMP = WS_AL + al1((size_t)MPAD * DM * 2);
constexpr size_t WS_MG = WS_TMP + al1((size_t)MPAD * DM * 4);
constexpr size_t WS_X = WS_MG + al1((size_t)MPAD * DM * 2);
constexpr size_t WS_END = WS_X + al1((size_t)MPAD * DM * 4);
constexpr int CW_BAR = 4096;

constexpr int RING_BYTES = 131072;
constexpr int LDSCTL_OFF = RING_BYTES;
constexpr int LDSBIAS_OFF = RING_BYTES + 512;
constexpr int LDS_BYTES = 147456;

#define LDS_WAIT() asm volatile("s_waitcnt lgkmcnt(0)" ::: "memory")
#define VM_WAIT() asm volatile("s_waitcnt vmcnt(0)" ::: "memory")

__device__ __forceinline__ unsigned pk2(float lo, float hi) { return pg8::cvt_pk_bf16(lo, hi); }
__device__ __forceinline__ float bflo(unsigned w) { return __uint_as_float(w << 16); }
__device__ __forceinline__ float bfhi(unsigned w) { return __uint_as_float(w & 0xffff0000u); }
__device__ __forceinline__ float bf1(bf16 v) { return __uint_as_float(((unsigned)v) << 16); }
__device__ __forceinline__ float sigm(float v) { return __builtin_amdgcn_rcpf(1.0f + __expf(-v)); }
__device__ __forceinline__ float shfl_x(float v, int m, int lane) { return __builtin_bit_cast(float, __builtin_amdgcn_ds_bpermute((lane ^ m) << 2, __builtin_bit_cast(int, v))); }
__device__ __forceinline__ float shfl_u(float v, int d, int lane) { const int src = lane - d; return __builtin_bit_cast(float, __builtin_amdgcn_ds_bpermute((src < 0 ? lane : src) << 2, __builtin_bit_cast(int, v))); }
__device__ __forceinline__ float wave_sum(float v, int lane) {
#pragma unroll
    for (int o = 1; o < 64; o <<= 1) v += shfl_x(v, o, lane);
    return v;
}
__device__ __forceinline__ float wave_max(float v, int lane) {
#pragma unroll
    for (int o = 1; o < 64; o <<= 1) v = fmaxf(v, shfl_x(v, o, lane));
    return v;
}
__device__ __forceinline__ int t5_bucket(int d) {
    if (d < 16) return d;
    int b = 16;
    b += (d >= 22); b += (d >= 30); b += (d >= 40); b += (d >= 54); b += (d >= 73); b += (d >= 99); b += (d >= 134); b += (d >= 182);
    b += (d >= 246); b += (d >= 332); b += (d >= 450); b += (d >= 609); b += (d >= 825); b += (d >= 1117); b += (d >= 1513);
    return b;
}

__device__ __forceinline__ int hw_lane() { int l; asm volatile("v_mbcnt_lo_u32_b32 %0, -1, 0\n\tv_mbcnt_hi_u32_b32 %0, -1, %0" : "=v"(l)); return l; }
struct Args { const float* in[25]; float* out; unsigned char* ws; int ph_lo, ph_hi, li, pad; };
enum InIdx { I_XP = 0, I_XS, I_CP, I_CS, I_C0, I_C1, I_C2, I_SCONV, I_SH, I_RELB, I_WADA, I_BADA, I_NORMG, I_WIN, I_CONVW, I_CONVB, I_WR, I_BR, I_WI, I_BI, I_LAM, I_WPA, I_WPB, I_WOUT, I_FING };

struct Frame {
    LAS unsigned char* lds;
    int tid, lane, wave, vcu, G;
    GAS float* out; GAS unsigned char* ws;
};
typedef const __attribute__((address_space(4))) Args* KArgs;
__device__ __forceinline__ KArgs kargs() { KArgs p = (KArgs)__builtin_amdgcn_kernarg_segment_ptr(); asm volatile("" : "+s"(p)); return p; }
#define KIN(A, NAME) ((const float*)(const GAS float*)(A)->in[I_##NAME])
__device__ __forceinline__ Frame fresh(const Frame& F0) {
    Frame F = F0; int lane = hw_lane();
    asm volatile("" : "+v"(lane), "+s"(F.ws), "+s"(F.out), "+s"(F.vcu), "+s"(F.wave), "+s"(F.G)); F.lane = lane; F.tid = F.wave * 64 + lane; return F; }


constexpr int KVC_S0 = (128 - 4) * 512, KVC_S1 = (512 - 4) * 512, KVC_S2 = (2048 - 4) * 512;
constexpr int KVC_C1 = DEPTH * NB_S * KVC_S0, KVC_C2 = KVC_C1 + DEPTH * NB_S * KVC_S1, KVC_TOTAL = KVC_C2 + DEPTH * NB_S * KVC_S2;
constexpr int KVC_RIDE = 4;
constexpr int KVC_LRIDE = 1;
constexpr int KVC_LQ = KVC_TOTAL / 4, KVC_LAYER = 2191872, KVC_ATT = 1536 * 512 * KVC_RIDE, KVC_LRU = 256 * 16 * 512 * KVC_LRIDE, KVC_REM = KVC_LQ - KVC_LAYER - KVC_ATT - KVC_LRU;
static_assert(KVC_TOTAL % 4 == 0 && KVC_REM >= 0, "copy partition");
static_assert(KVC_LAYER >= KVC_C1 && KVC_LAYER + KVC_ATT + KVC_LRU <= KVC_C2 && KVC_LQ + KVC_LAYER >= KVC_C2 && KVC_LAYER % 512 == 0, "riding ranges vs. group boundaries");
__device__ __forceinline__ void kvc_map(KArgs A, GAS float* out, int i, const f32x4*& sp, f32x4*& dp) {
    int j = i, W, S; const f32x4* sb; GAS f32x4* db;
    if (j < KVC_C1) { W = 128; S = KVC_S0; sb = (const f32x4*)KIN(A, C0); db = (GAS f32x4*)(out + O_KVS0); }
    else if (j < KVC_C2) { j -= KVC_C1; W = 512; S = KVC_S1; sb = (const f32x4*)KIN(A, C1); db = (GAS f32x4*)(out + O_KVS1); }
    else { j -= KVC_C2; W = 2048; S = KVC_S2; sb = (const f32x4*)KIN(A, C2); db = (GAS f32x4*)(out + O_KVS2); }
    const int sg = j / S, of = j - sg * S; const size_t o = (size_t)sg * W * 512 + of; sp = sb + o + 2048; dp = (f32x4*)(db + o);
}
__device__ __forceinline__ void kvc_map1(KArgs A, GAS float* out, int grp, int i, const f32x4*& sp, f32x4*& dp) {
    const int W = grp == 0 ? 128 : (grp == 1 ? 512 : 2048), S = grp == 0 ? KVC_S0 : (grp == 1 ? KVC_S1 : KVC_S2), j = i - (grp == 0 ? 0 : (grp == 1 ? KVC_C1 : KVC_C2));
    const f32x4* sb = (const f32x4*)(grp == 0 ? KIN(A, C0) : (grp == 1 ? KIN(A, C1) : KIN(A, C2)));
    GAS f32x4* db = (GAS f32x4*)(out + (grp == 0 ? O_KVS0 : (grp == 1 ? O_KVS1 : O_KVS2)));
    const int sg = j / S, of = j - sg * S; const size_t o = (size_t)sg * W * 512 + of; sp = sb + o + 2048; dp = (f32x4*)(db + o);
}
__device__ __forceinline__ void kvcopy_range(const Frame& F, int i0, int i1, int tix, int nth) {
    const KArgs A = kargs();
    int i = i0 + tix;
#pragma unroll 1
    for (; i + 15 * nth < i1; i += 16 * nth) {
        f32x4 v[16]; f32x4* dp[16];
#pragma unroll
        for (int j = 0; j < 16; ++j) { const f32x4* sp; kvc_map(A, F.out, i + j * nth, sp, dp[j]); v[j] = __builtin_nontemporal_load(sp); }
#pragma unroll
        for (int j = 0; j < 16; ++j) __builtin_nontemporal_store(v[j], dp[j]);
    }
#pragma unroll 1
    for (; i < i1; i += nth) { const f32x4* sp; f32x4* dp; kvc_map(A, F.out, i, sp, dp); __builtin_nontemporal_store(__builtin_nontemporal_load(sp), dp); }
}
struct BgCopy4 {
    f32x4 v[4]; f32x4* dp[4];
    __device__ __forceinline__ void request(GAS float* out, int start, int tid) {
        const KArgs A = kargs();
#pragma unroll
        for (int j = 0; j < 4; ++j) { const f32x4* sp; kvc_map(A, out, start + j * 512 + tid, sp, dp[j]); v[j] = __builtin_nontemporal_load(sp); }
        asm volatile("" ::: "memory");
    }
    __device__ __forceinline__ void finish() {
        asm volatile("" ::: "memory");
#pragma unroll
        for (int j = 0; j < 4; ++j) __builtin_nontemporal_store(v[j], dp[j]);
    }
};
struct EpiIn {
    static constexpr bool PERM = true, AFTER_DRAIN = false;
    bf16 *Q, *K, *V, *ZA, *XL, *ZL, *GA, *GL; GAS float* out; int l;
    __device__ __forceinline__ void operator()(const pg8::f32x4 (&acc)[2][2][4][2], const pg8::Unit& u, int wr, int wc, int fr, int fq) const {
        const int row0 = u.pm * 256 + wr * 64 + fr, ct = u.pn * 256, cl = wc * 32 + 8 * fq;
        GAS float* out = this->out; asm volatile("" : "+s"(out));
        int mode, ld, cc; bf16* base;
        if (ct < C_K) { mode = 0; base = Q; ld = QKVW; cc = ct; }
        else if (ct < C_V) { mode = 1; base = K; ld = QKVW; cc = ct - C_K; }
        else if (ct < C_ZA) { mode = 2; base = V; ld = QKVW; cc = ct - C_V; }
        else if (ct < C_XL) { mode = 3; base = ZA; ld = ATTW; cc = ct - C_ZA; }
        else if (ct < C_ZL) { mode = 4; base = XL; ld = DM; cc = ct - C_XL; }
        else if (ct < C_GA) { mode = 3; base = ZL; ld = DM; cc = ct - C_ZL; }
        else if (ct < C_GL) { mode = 5; base = GA; ld = DM; cc = ct - C_GA; }
        else { mode = 5; base = GL; ld = DM; cc = ct - C_GL; }
        const int gi = cc >> 10;
        const int Wg = gi == 0 ? 128 : (gi == 1 ? 512 : 2048);
        GAS float* kvp = out + (gi == 0 ? O_KVP0 : (gi == 1 ? O_KVP1 : O_KVP2));
        GAS float* kvs = out + (gi == 0 ? O_KVS0 : (gi == 1 ? O_KVS1 : O_KVS2));
#pragma unroll
        for (int ai = 0; ai < 2; ++ai)
#pragma unroll
            for (int m = 0; m < 4; ++m) {
                const int r = row0 + ai * 128 + m * 16;
                bf16* rowp = base + (size_t)r * ld + cc + cl;
                GAS float* f32dst = nullptr;
                if (mode == 1 || mode == 2) {
                    if (r < MP) { const int b = r >> 11, t = r & 2047; if (t >= TT - Wg) f32dst = kvp + (((size_t)(l * NB_P + b) * Wg + (t - (TT - Wg))) * 2 + (mode - 1)) * 1024 + (cc & 1023); }
                    else if (r < MR) { const int bs = (r - MP) >> 2, s = (r - MP) & 3; f32dst = kvs + (((size_t)(l * NB_S + bs) * Wg + (Wg - 4 + s)) * 2 + (mode - 1)) * 1024 + (cc & 1023); }
                } else if (mode == 4) {
                    if (r < MP) { const int b = r >> 11, t = r & 2047; if (t >= TT - 3) f32dst = out + O_CVP + ((size_t)(l * NB_P + b) * 3 + (t - (TT - 3))) * DM + cc; }
                    else if (r < MR) { const int bs = (r - MP) >> 2, s = (r - MP) & 3; if (s >= 1) f32dst = out + O_CVS + ((size_t)(l * NB_S + bs) * 3 + (s - 1)) * DM + cc; }
                }
#pragma unroll
                for (int bj = 0; bj < 2; ++bj) {
                    pg8::f32x4 v0 = acc[ai][bj][m][0], v1 = acc[ai][bj][m][1];
                    if (f32dst) { *(GAS pg8::f32x4*)(f32dst + cl + bj * 128) = v0; *(GAS pg8::f32x4*)(f32dst + cl + bj * 128 + 4) = v1; }
                    if (mode == 0) { v0 = v0 * QSCALE; v1 = v1 * QSCALE; }
                    else if (mode == 3) {
#pragma unroll
                        for (int j = 0; j < 4; ++j) { v0[j] = v0[j] * sigm(v0[j]); v1[j] = v1[j] * sigm(v1[j]); }
                    } else if (mode == 5) {
#pragma unroll
                        for (int j = 0; j < 4; ++j) { v0[j] = sigm(v0[j]); v1[j] = sigm(v1[j]); }
                    }
                    u32x4 w; w.x = pk2(v0[0], v0[1]); w.y = pk2(v0[2], v0[3]); w.z = pk2(v1[0], v1[1]); w.w = pk2(v1[2], v1[3]);
                    *(u32x4*)(rowp + bj * 128) = w;
                }
            }
    }
};
struct EpiPA {
    static constexpr bool PERM = true, AFTER_DRAIN = false;
    const bf16* GA; bf16* TMP;
    __device__ __forceinline__ void operator()(const pg8::f32x4 (&acc)[2][2][4][2], const pg8::Unit& u, int wr, int wc, int fr, int fq) const {
        const int row0 = u.pm * 256 + wr * 64 + fr, col0 = u.pn * 256 + wc * 32 + 8 * fq;
#pragma unroll
        for (int ai = 0; ai < 2; ++ai)
#pragma unroll
            for (int m = 0; m < 4; ++m) {
                const size_t ro = (size_t)(row0 + ai * 128 + m * 16) * DM + col0;
#pragma unroll
                for (int bj = 0; bj < 2; ++bj) {
                    const u32x4 g = *(const u32x4*)(GA + ro + bj * 128);
                    pg8::f32x4 v0 = acc[ai][bj][m][0], v1 = acc[ai][bj][m][1];
                    v0[0] *= bflo(g.x); v0[1] *= bfhi(g.x); v0[2] *= bflo(g.y); v0[3] *= bfhi(g.y);
                    v1[0] *= bflo(g.z); v1[1] *= bfhi(g.z); v1[2] *= bflo(g.w); v1[3] *= bfhi(g.w);
                    u32x4 w; w.x = pk2(v0[0], v0[1]); w.y = pk2(v0[2], v0[3]); w.z = pk2(v1[0], v1[1]); w.w = pk2(v1[2], v1[3]);
                    *(u32x4*)(TMP + ro + bj * 128) = w;
                }
                asm volatile("" ::: "memory");
            }
    }
};
struct EpiPB {
    static constexpr bool PERM = true, AFTER_DRAIN = false;
    const bf16* GL; const bf16* TMP; bf16* MG;
    __device__ __forceinline__ void operator()(const pg8::f32x4 (&acc)[2][2][4][2], const pg8::Unit& u, int wr, int wc, int fr, int fq) const {
        const int row0 = u.pm * 256 + wr * 64 + fr, col0 = u.pn * 256 + wc * 32 + 8 * fq;
#pragma unroll
        for (int ai = 0; ai < 2; ++ai)
#pragma unroll
            for (int m = 0; m < 4; ++m) {
                const size_t ro = (size_t)(row0 + ai * 128 + m * 16) * DM + col0;
#pragma unroll
                for (int bj = 0; bj < 2; ++bj) {
                    const u32x4 g = *(const u32x4*)(GL + ro + bj * 128);
                    const u32x4 tw = *(const u32x4*)(TMP + ro + bj * 128);
                    const pg8::f32x4 t0 = (pg8::f32x4){bflo(tw.x), bfhi(tw.x), bflo(tw.y), bfhi(tw.y)}, t1 = (pg8::f32x4){bflo(tw.z), bfhi(tw.z), bflo(tw.w), bfhi(tw.w)};
                    pg8::f32x4 v0 = acc[ai][bj][m][0], v1 = acc[ai][bj][m][1];
                    v0[0] = t0[0] + v0[0] * bflo(g.x); v0[1] = t0[1] + v0[1] * bfhi(g.x); v0[2] = t0[2] + v0[2] * bflo(g.y); v0[3] = t0[3] + v0[3] * bfhi(g.y);
                    v1[0] = t1[0] + v1[0] * bflo(g.z); v1[1] = t1[1] + v1[1] * bfhi(g.z); v1[2] = t1[2] + v1[2] * bflo(g.w); v1[3] = t1[3] + v1[3] * bfhi(g.w);
                    u32x4 w; w.x = pk2(v0[0], v0[1]); w.y = pk2(v0[2], v0[3]); w.z = pk2(v1[0], v1[1]); w.w = pk2(v1[2], v1[3]);
                    *(u32x4*)(MG + ro + bj * 128) = w;
                }
                asm volatile("" ::: "memory");
            }
    }
};
struct EpiMerge {
    static constexpr bool PERM = true, AFTER_DRAIN = false;
    const bf16* GA; const bf16* GL; bf16* MG;
    static __device__ __forceinline__ float clampg(float g) { return fmaxf(g, 8.673617379884035e-19f); }
    __device__ __forceinline__ void mid(pg8::f32x4 (&acc)[2][2][4][2], const pg8::Unit& u, int wr, int wc, int fr, int fq) const {
        const GAS bf16* GA = (const GAS bf16*)this->GA; const GAS bf16* GL = (const GAS bf16*)this->GL; asm volatile("" : "+s"(GA), "+s"(GL), "+v"(fr), "+v"(fq));
        const int row0 = u.pm * 256 + wr * 64 + fr, col0 = u.pn * 256 + wc * 32 + 8 * fq;
#pragma unroll
        for (int ai = 0; ai < 2; ++ai)
#pragma unroll
            for (int mp = 0; mp < 4; mp += 2) {
                u32x4 a[2][2], g[2][2];
#pragma unroll
                for (int mm = 0; mm < 2; ++mm)
#pragma unroll
                    for (int bj = 0; bj < 2; ++bj) { const size_t ro = (size_t)(row0 + ai * 128 + (mp + mm) * 16) * DM + col0 + bj * 128; a[mm][bj] = *(const GAS u32x4*)(GA + ro); g[mm][bj] = *(const GAS u32x4*)(GL + ro); }
#pragma unroll
                for (int mm = 0; mm < 2; ++mm) {
#pragma unroll
                    for (int bj = 0; bj < 2; ++bj)
#pragma unroll
                        for (int e = 0; e < 4; ++e) {
                            acc[ai][bj][mp + mm][e >> 1][2 * (e & 1)] *= bflo(a[mm][bj][e]) * __builtin_amdgcn_rcpf(clampg(bflo(g[mm][bj][e])));
                            acc[ai][bj][mp + mm][e >> 1][2 * (e & 1) + 1] *= bfhi(a[mm][bj][e]) * __builtin_amdgcn_rcpf(clampg(bfhi(g[mm][bj][e])));
                        }
                    asm volatile("" : "+v"(acc[ai][0][mp + mm][0]), "+v"(acc[ai][0][mp + mm][1]), "+v"(acc[ai][1][mp + mm][0]), "+v"(acc[ai][1][mp + mm][1]) :: "memory");
                }
            }
    }
    __device__ __forceinline__ void operator()(const pg8::f32x4 (&acc)[2][2][4][2], const pg8::Unit& u, int wr, int wc, int fr, int fq) const {
        const GAS bf16* GL = (const GAS bf16*)this->GL; GAS bf16* MG = (GAS bf16*)this->MG; asm volatile("" : "+s"(GL), "+s"(MG), "+v"(fr), "+v"(fq));
        const int row0 = u.pm * 256 + wr * 64 + fr, col0 = u.pn * 256 + wc * 32 + 8 * fq;
#pragma unroll
        for (int ai = 0; ai < 2; ++ai)
#pragma unroll
            for (int mp = 0; mp < 4; mp += 2) {
                u32x4 g[2][2];
#pragma unroll
                for (int mm = 0; mm < 2; ++mm)
#pragma unroll
                    for (int bj = 0; bj < 2; ++bj) g[mm][bj] = *(const GAS u32x4*)(GL + (size_t)(row0 + ai * 128 + (mp + mm) * 16) * DM + col0 + bj * 128);
#pragma unroll
                for (int mm = 0; mm < 2; ++mm)
#pragma unroll
                    for (int bj = 0; bj < 2; ++bj) {
                        u32x4 w;
#pragma unroll
                        for (int e = 0; e < 4; ++e) w[e] = pk2(acc[ai][bj][mp + mm][e >> 1][2 * (e & 1)] * clampg(bflo(g[mm][bj][e])), acc[ai][bj][mp + mm][e >> 1][2 * (e & 1) + 1] * clampg(bfhi(g[mm][bj][e])));
                        *(GAS u32x4*)(MG + (size_t)(row0 + ai * 128 + (mp + mm) * 16) * DM + col0 + bj * 128) = w;
                    }
                asm volatile("" ::: "memory");
            }
    }
};
struct EpiOut {
    static constexpr bool PERM = false, AFTER_DRAIN = false;
    const float* xp; const float* xs; float* X; const float* mod; int l;
    __device__ __forceinline__ void operator()(const pg8::f32x4 (&acc)[2][2][4][2], const pg8::Unit& u, int wr, int wc, int fr, int fq) const {
        const GAS float* xo = (const GAS float*)(l == 0 ? xp : X); GAS float* Xn = (GAS float*)X; const GAS float* gp = (const GAS float*)mod + ((size_t)(l * NMODB + (u.pm >> 3))) * 6144 + 4096;
        asm volatile("" : "+s"(xo), "+s"(Xn), "+s"(gp), "+v"(fr), "+v"(fq));
        const int row0 = u.pm * 256 + wr * 64 + fr, col0 = u.pn * 256 + wc * 32 + 4 * fq;
        pg8::f32x4 g4[2][2];
#pragma unroll
        for (int bj = 0; bj < 2; ++bj)
#pragma unroll
            for (int n = 0; n < 2; ++n) g4[bj][n] = *(const GAS pg8::f32x4*)(gp + col0 + bj * 128 + n * 16);
#pragma unroll
        for (int ai = 0; ai < 2; ++ai)
#pragma unroll
            for (int mp = 0; mp < 4; mp += 2) {
                pg8::f32x4 x4[2][2][2];
#pragma unroll
                for (int mm = 0; mm < 2; ++mm)
#pragma unroll
                    for (int bj = 0; bj < 2; ++bj)
#pragma unroll
                        for (int n = 0; n < 2; ++n) x4[mm][bj][n] = *(const GAS pg8::f32x4*)(xo + (size_t)(row0 + ai * 128 + (mp + mm) * 16) * DM + col0 + bj * 128 + n * 16);
#pragma unroll
                for (int mm = 0; mm < 2; ++mm)
#pragma unroll
                    for (int bj = 0; bj < 2; ++bj)
#pragma unroll
                        for (int n = 0; n < 2; ++n) *(GAS pg8::f32x4*)(Xn + (size_t)(row0 + ai * 128 + (mp + mm) * 16) * DM + col0 + bj * 128 + n * 16) = x4[mm][bj][n] + g4[bj][n] * acc[ai][bj][mp + mm][n];
                asm volatile("" ::: "memory");
            }
    }
};
#define XB_TMO      128
#define XB_XCNT(j)  (256  + 64 * (j))
#define XB_XSUB(j)  (1280 + 64 * (j))
#define XB_XGEN(j)  (2304 + 64 * (j))
#define XB_TOP      3328
#define XB_TOPGEN   3392
#define XCD_BAR_WORDS 3456
#define XB_SPIN_CAP (1u << 18)

__device__ __forceinline__ unsigned xb_ld(unsigned* p)              { return __hip_atomic_load(p, __ATOMIC_RELAXED, __HIP_MEMORY_SCOPE_AGENT); }
__device__ __forceinline__ unsigned xb_add(unsigned* p, unsigned v) { return __hip_atomic_fetch_add(p, v, __ATOMIC_RELAXED, __HIP_MEMORY_SCOPE_AGENT); }
__device__ __forceinline__ unsigned xb_xcc_id() { return (unsigned)__builtin_amdgcn_s_getreg((3 << 11) | 20) & 0xFu; }
#define XB_SPIN(cond, bar) do { unsigned _sp = 0; while (cond) { __builtin_amdgcn_s_sleep(1); \
    if ((++_sp & 255u) == 0u) { if (xb_ld(&(bar)[XB_TMO])) break; if (_sp > XB_SPIN_CAP) { atomicAdd(&(bar)[XB_TMO], 1u); break; } } } } while (0)

struct XcdBarrier {
    unsigned* bar; unsigned x;
    volatile LAS unsigned* st;
};

__device__ __forceinline__ XcdBarrier xcd_barrier_post(unsigned* bar, volatile LAS unsigned* st) {
    XcdBarrier b; b.bar = bar; b.x = xb_xcc_id(); b.st = st;
    if (threadIdx.x == 0) (void)xb_add(&bar[XB_XCNT(b.x)], 1u);
    return b;
}
__device__ __forceinline__ void xcd_barrier_complete(unsigned* bar, unsigned x, unsigned& nloc, unsigned& nx) {
    const unsigned G = gridDim.x * gridDim.y * gridDim.z;
    unsigned sum, cnt, mine, sp = 0u;
    for (;;) {
        sum = 0u; cnt = 0u; mine = 0u;
#pragma unroll
        for (unsigned j = 0; j < 16; ++j) { const unsigned c = xb_ld(&bar[XB_XCNT(j)]); sum += c; cnt += (c > 0u) ? 1u : 0u; mine = (j == x) ? c : mine; }
        if (sum == G) break;
        __builtin_amdgcn_s_sleep(1);
        if ((++sp & 255u) == 0u) { if (xb_ld(&bar[XB_TMO])) break; if (sp > XB_SPIN_CAP) { atomicAdd(&bar[XB_TMO], 1u); break; } }
    }
    nloc = mine > 0u ? mine : 1u; nx = cnt > 0u ? cnt : 1u;
}

__device__ __forceinline__ void xcd_barrier(const XcdBarrier& b, bool is_t0  ) {
    asm volatile("s_waitcnt vmcnt(0)" ::: "memory");
    __syncthreads();
    if (is_t0) {
        unsigned* bar = b.bar;
        __builtin_amdgcn_s_waitcnt(0);
        unsigned nloc = b.st[0], nx = b.st[1];
        if (nloc == 0u) { xcd_barrier_complete(bar, b.x, nloc, nx); b.st[0] = nloc; b.st[1] = nx; }
        const unsigned old = xb_add(&bar[XB_XSUB(b.x)], 1u);
        const unsigned gen = old / nloc;
        if (old + 1u == (gen + 1u) * nloc) {
            __builtin_amdgcn_fence(__ATOMIC_RELEASE, "agent");
            asm volatile("s_waitcnt vmcnt(0)" ::: "memory");
            const unsigned og = xb_add(&bar[XB_TOP], 1u);
            const unsigned tg = og / nx;
            if (og + 1u == (tg + 1u) * nx) xb_add(&bar[XB_TOPGEN], 1u);
            else XB_SPIN(xb_ld(&bar[XB_TOPGEN]) == tg, bar);
            __builtin_amdgcn_fence(__ATOMIC_ACQUIRE, "agent");
            xb_add(&bar[XB_XGEN(b.x)], 1u);
            asm volatile("s_waitcnt vmcnt(0)" ::: "memory");
        } else {
            XB_SPIN(xb_ld(&bar[XB_XGEN(b.x)]) == gen, bar);
            __builtin_amdgcn_fence(__ATOMIC_ACQUIRE, "agent");
            asm volatile("s_waitcnt vmcnt(0)" ::: "memory");
        }
    }
    __syncthreads();
}

struct TrDesc { const float* W; bf16* WT; int K, N, item, ldt; };
__device__ __forceinline__ void tr_load(const TrDesc& d, int lane, f32x4 (&v)[16]) {
    const int nblk = d.N >> 6, kb = d.item / nblk, nb = d.item - kb * nblk, k0 = kb * 64, n0 = nb * 64, lr = lane >> 4, lc = lane & 15;
#pragma unroll
    for (int i = 0; i < 16; ++i) v[i] = __builtin_nontemporal_load((const f32x4*)(d.W + (size_t)(k0 + 4 * i + lr) * d.N + n0 + 4 * lc));
}
__device__ __forceinline__ void tr_to_lds(LAS float* scr, int lane, const f32x4 (&v)[16]) {
    const int lr = lane >> 4, lc = lane & 15;
#pragma unroll
    for (int i = 0; i < 16; ++i) { const int k = 4 * i + lr; *(LAS f32x4*)(scr + k * 64 + ((lc ^ ((k >> 3) & 7)) << 2)) = v[i]; }
}
__device__ __forceinline__ void tr_store(const TrDesc& d, LAS float* scr, int lane) {
    const int nblk = d.N >> 6, kb = d.item / nblk, nb = d.item - kb * nblk, k0 = kb * 64, n0 = nb * 64;
    const int c = lane & 7;
#pragma unroll
    for (int j = 0; j < 8; ++j) {
        const int n = (lane >> 3) + 8 * j;
        const LAS float* s = scr + (8 * c) * 64 + (((n >> 2) ^ c) << 2) + (n & 3);
        u32x4 o; o.x = pk2(s[0 * 64], s[1 * 64]); o.y = pk2(s[2 * 64], s[3 * 64]); o.z = pk2(s[4 * 64], s[5 * 64]); o.w = pk2(s[6 * 64], s[7 * 64]);
        *(u32x4*)(d.WT + (size_t)(n0 + n) * d.ldt + k0 + 8 * c) = o;
    }
}
__device__ __forceinline__ void mod_item(const Frame& F, LAS float* scr, int item) {
    const KArgs A = kargs();
    int lane = F.lane; asm volatile("" : "+v"(lane));
    const int l = item / 384, r = item - l * 384, cg = r >> 4, kc = r & 15;
    const float* cp = KIN(A, CP); const float* cs = KIN(A, CS);
    for (int idx = lane; idx < NMODB * 128; idx += 64) {
        const int b = idx >> 7, k = idx & 127;
        const float cv = b < NB_P ? cp[b * DM + kc * 128 + k] : cs[(b - NB_P) * DM + kc * 128 + k];
        scr[k * 16 + b] = cv * sigm(cv);
    }
    LDS_WAIT();
    f32x4 acc[NMODB];
#pragma unroll
    for (int b = 0; b < NMODB; ++b) acc[b] = (f32x4){0.f, 0.f, 0.f, 0.f};
    const float* wp = KIN(A, WADA) + (size_t)l * DM * 6144 + (size_t)(kc * 128) * 6144 + cg * 256 + lane * 4;
#pragma unroll 16
    for (int k = 0; k < 128; ++k) {
        const f32x4 w = __builtin_nontemporal_load((const f32x4*)(wp + (size_t)k * 6144));
        const f32x4 s0 = *(const LAS f32x4*)(scr + k * 16), s1 = *(const LAS f32x4*)(scr + k * 16 + 4), s2 = *(const LAS f32x4*)(scr + k * 16 + 8);
        acc[0] += s0[0] * w; acc[1] += s0[1] * w; acc[2] += s0[2] * w; acc[3] += s0[3] * w;
        acc[4] += s1[0] * w; acc[5] += s1[1] * w; acc[6] += s1[2] * w; acc[7] += s1[3] * w;
        acc[8] += s2[0] * w; acc[9] += s2[1] * w; acc[10] += s2[2] * w; acc[11] += s2[3] * w;
    }
    float* mp = (float*)(F.ws + WS_MODP) + ((size_t)(l * 16 + kc) * NMODB) * 6144 + cg * 256 + lane * 4;
#pragma unroll
    for (int b = 0; b < NMODB; ++b) *(f32x4*)(mp + (size_t)b * 6144) = acc[b];
    LDS_WAIT();
}
__device__ __forceinline__ void p0_prologue(const Frame& F) {
    const KArgs A = kargs();
    LAS float* scr = (LAS float*)(F.lds + F.wave * 16384);
    const int gw = F.vcu * 8 + F.wave, NGW = F.G * 8;
    constexpr int I_IN = 32 * 288, I_PA = 16 * 32, I_PB = 32 * 32, I_OUT = 32 * 32, I_RI = 16 * 4;
    constexpr int PER_L = I_IN + I_PA + I_PB + I_OUT + 2 * I_RI, NTR = DEPTH * PER_L, NMOD = DEPTH * 24 * 16;
    auto decode = [&](int it) -> TrDesc {
        TrDesc d; const int l = it / PER_L; int r = it - l * PER_L;
        if (r < I_IN) { d.W = KIN(A, WIN) + (size_t)l * DM * INC; d.K = DM; d.N = INC; d.ldt = DM; d.WT = (bf16*)(F.ws + WS_WIN) + (size_t)l * INC * DM; d.item = r; return d; } r -= I_IN;
        if (r < I_PA) { d.W = KIN(A, WPA) + (size_t)l * ATTW * DM; d.K = ATTW; d.N = DM; d.ldt = DM; d.WT = (bf16*)(F.ws + WS_WPA) + (size_t)l * DM * DM; d.item = r; return d; } r -= I_PA;
        if (r < I_PB) { d.W = KIN(A, WPB) + (size_t)l * DM * DM; d.K = DM; d.N = DM; d.ldt = DM; d.WT = (bf16*)(F.ws + WS_WPB) + (size_t)l * DM * DM; d.item = r; return d; } r -= I_PB;
        if (r < I_OUT) { d.W = KIN(A, WOUT) + (size_t)l * DM * DM; d.K = DM; d.N = DM; d.ldt = DM; d.WT = (bf16*)(F.ws + WS_WOUT) + (size_t)l * DM * DM; d.item = r; return d; } r -= I_OUT;
        if (r < I_RI) { const int nb = r >> 2; d.W = KIN(A, WR) + (size_t)(l * 16 + nb) * 16384; d.K = 128; d.N = 128; d.ldt = 128; d.WT = (bf16*)(F.ws + WS_WR) + (size_t)(l * 16 + nb) * 16384; d.item = r & 3; return d; } r -= I_RI;
        { const int nb = r >> 2; d.W = KIN(A, WI) + (size_t)(l * 16 + nb) * 16384; d.K = 128; d.N = 128; d.ldt = 128; d.WT = (bf16*)(F.ws + WS_WI) + (size_t)(l * 16 + nb) * 16384; d.item = r & 3; return d; }
    };
    {
        f32x4 va[16], vb[16]; int it = gw; TrDesc d0{}, d1{};
        if (it < NTR) { d0 = decode(it); tr_load(d0, F.lane, va); }
        if (it + NGW < NTR) { d1 = decode(it + NGW); tr_load(d1, F.lane, vb); }
#pragma unroll 1
        while (it < NTR) {
            int lane = F.lane; asm volatile("" : "+v"(lane));
            {
                tr_to_lds(scr, lane, va); LDS_WAIT();
                const int nx = it + 2 * NGW; TrDesc dn{};
                if (nx < NTR) { dn = decode(nx); tr_load(dn, lane, va); }
                tr_store(d0, scr, lane); LDS_WAIT();
                d0 = dn;
            }
            if (it + NGW < NTR) {
                tr_to_lds(scr, lane, vb); LDS_WAIT();
                const int nx = it + 3 * NGW; TrDesc dn{};
                if (nx < NTR) { dn = decode(nx); tr_load(dn, lane, vb); }
                tr_store(d1, scr, lane); LDS_WAIT();
                d1 = dn;
            }
            it += 2 * NGW;
        }
    }
#pragma unroll 1
    for (int it = gw; it < NMOD; it += NGW) mod_item(F, scr, it);
#pragma unroll 1
    for (int qq = 0; qq < 4; ++qq) kvcopy_range(F, (qq + 1) * KVC_LQ - KVC_REM, (qq + 1) * KVC_LQ, (F.vcu * 8 + F.wave) * 64 + F.lane, F.G * 512);
}
__device__ __forceinline__ void p1_modreduce(const Frame& F) {
    const KArgs A = kargs();
    const int gt = (F.vcu * 8 + F.wave) * 64 + F.lane, NT = F.G * 512;
    const float* modp = (const float*)(F.ws + WS_MODP); float* mod = (float*)(F.ws + WS_MOD);
    for (int i = gt; i < DEPTH * NMODB * 6144; i += NT) {
        const int l = i / (NMODB * 6144), r = i - l * (NMODB * 6144), b = r / 6144, n = r - b * 6144;
        float s = KIN(A, BADA)[l * 6144 + n];
#pragma unroll
        for (int kc = 0; kc < 16; ++kc) s += modp[((size_t)(l * 16 + kc) * NMODB + b) * 6144 + n];
        mod[i] = s;
    }
}
__device__ __forceinline__ float sumsq8(const f32x4 (&v)[8]) {
    float ss = 0.f;
#pragma unroll
    for (int j = 0; j < 8; ++j) ss += (v[j][0] * v[j][0] + v[j][1] * v[j][1]) + (v[j][2] * v[j][2] + v[j][3] * v[j][3]);
    return ss;
}
__device__ __forceinline__ void phase_norm(const Frame& F, int l) {
    const KArgs A = kargs();
    const int gw = F.vcu * 8 + F.wave, NGW = F.G * 8, lane = F.lane;
    bf16* H = (bf16*)(F.ws + WS_H); const float* X = (const float*)(F.ws + WS_X); const float* mod = (const float*)(F.ws + WS_MOD);
    const f32x4* g4 = (const f32x4*)(KIN(A, NORMG) + l * DM);
#pragma unroll 1
    for (int r0 = 4 * gw; r0 < MP + 4 * MS; r0 += 4 * NGW) {
        const bool prompt = r0 < MP; const int rbase = prompt ? r0 : MP + ((r0 - MP) >> 2), nrow = prompt ? 4 : 1;
        const int b = prompt ? (rbase >> 11) : NB_P + ((rbase - MP) >> 2);
        const float* xbase = (l == 0) ? (prompt ? KIN(A, XP) + (size_t)rbase * DM : KIN(A, XS) + (size_t)(rbase - MP) * DM) : X + (size_t)rbase * DM;
        const f32x4* sh4 = (const f32x4*)(mod + (size_t)(l * NMODB + b) * 6144); const f32x4* sc4 = sh4 + 512;
        f32x4 v[8], vn[8], G[8], S[8];
#pragma unroll
        for (int j = 0; j < 8; ++j) v[j] = ((const f32x4*)xbase)[lane + 64 * j];
#pragma unroll
        for (int j = 0; j < 8; ++j) { G[j] = g4[lane + 64 * j] * (sc4[lane + 64 * j] + 1.0f); S[j] = sh4[lane + 64 * j]; }
#pragma unroll
        for (int k = 0; k < 4; ++k) if (k < nrow) {
            if (k + 1 < nrow) {
#pragma unroll
                for (int j = 0; j < 8; ++j) vn[j] = ((const f32x4*)(xbase + (size_t)(k + 1) * DM))[lane + 64 * j];
            }
            const float rstd = 1.0f / sqrtf(wave_sum(sumsq8(v), lane) * (1.0f / DM) + RMS_EPS);
            u32x2* ho = (u32x2*)(H + (size_t)(rbase + k) * DM) + lane;
#pragma unroll
            for (int j = 0; j < 8; ++j) { const f32x4 o = (v[j] * rstd) * G[j] + S[j]; ho[64 * j] = (u32x2){pk2(o[0], o[1]), pk2(o[2], o[3])}; }
#pragma unroll
            for (int j = 0; j < 8; ++j) v[j] = vn[j];
        }
    }
}
__device__ __forceinline__ void phase_final(const Frame& F) {
    const KArgs A = kargs();
    const int gw = F.vcu * 8 + F.wave, NGW = F.G * 8, lane = F.lane;
    const float* X = (const float*)(F.ws + WS_X); const f32x4* g4 = (const f32x4*)KIN(A, FING);
    f32x4 G[8];
#pragma unroll
    for (int j = 0; j < 8; ++j) G[j] = g4[lane + 64 * j];
#pragma unroll 1
    for (int r0 = 4 * gw; r0 < MP + 4 * MS; r0 += 4 * NGW) {
        const bool prompt = r0 < MP; const int rbase = prompt ? r0 : MP + ((r0 - MP) >> 2), nrow = prompt ? 4 : 1;
        const float* xbase = X + (size_t)rbase * DM;
        float* ybase = (float*)F.out + (prompt ? O_YP + (size_t)rbase * DM : O_YS + (size_t)(rbase - MP) * DM);
        f32x4 v[8], vn[8];
#pragma unroll
        for (int j = 0; j < 8; ++j) v[j] = ((const f32x4*)xbase)[lane + 64 * j];
#pragma unroll
        for (int k = 0; k < 4; ++k) if (k < nrow) {
            if (k + 1 < nrow) {
#pragma unroll
                for (int j = 0; j < 8; ++j) vn[j] = ((const f32x4*)(xbase + (size_t)(k + 1) * DM))[lane + 64 * j];
            }
            const float rstd = 1.0f / sqrtf(wave_sum(sumsq8(v), lane) * (1.0f / DM) + RMS_EPS);
            f32x4* yo = (f32x4*)(ybase + (size_t)k * DM) + lane;
#pragma unroll
            for (int j = 0; j < 8; ++j) yo[64 * j] = (v[j] * rstd) * G[j];
#pragma unroll
            for (int j = 0; j < 8; ++j) v[j] = vn[j];
        }
    }
}

__device__ __forceinline__ pg8::f32x4 mfma16(bf16x8 a, bf16x8 b, pg8::f32x4 c) { return __builtin_amdgcn_mfma_f32_16x16x32_bf16(a, b, c, 0, 0, 0); }
__device__ __forceinline__ s16x4 tr16(const LAS unsigned char* p) { return __builtin_bit_cast(s16x4, __builtin_amdgcn_ds_read_tr16_b64_v4i16((LAS s16x4*)p)); }

struct AttnU { int b, g, h, cls, n; };
__device__ __forceinline__ AttnU attn_decode(int id) {
    AttnU u; const int bh = id & 31, x = id >> 5, blk = x & 15; u.g = x >> 4; u.b = bh >> 3; u.h = bh & 7;
    u.cls = u.g == 0 ? 0 : (u.g == 1 ? (blk & 3) : blk); u.n = u.g == 0 ? blk : (u.g == 1 ? (blk >> 2) : 0); return u;
}
__device__ __forceinline__ void attn_request(const Frame& F, const AttnU& u, int tid, int wave, u32x4 (&kreg)[8], bf16x8 (&qf)[4]) {
    const bf16* Q = (const bf16*)(F.ws + WS_Q); const bf16* K = (const bf16*)(F.ws + WS_K);
    const int dil = u.g == 0 ? 1 : (u.g == 1 ? 4 : 16), gh = u.g * 8 + u.h, kk_lo = (u.n == 0) ? 128 : 0, npass = (256 - kk_lo) >> 5;
    const int c16 = tid & 15, rr = tid >> 4, lane = tid & 63;
#pragma unroll
    for (int p = 0; p < 8; ++p) if (p < npass) {
        const int kk = kk_lo + 32 * p + rr, uk = 128 * (u.n - 1) + kk;
        const size_t off = ((size_t)(u.b * TT + uk * dil + u.cls)) * QKVW + gh * 128 + c16 * 8;
        kreg[p] = *(const u32x4*)(K + off);
    }
    const size_t qrow = (size_t)(u.b * TT + (128 * u.n + 16 * wave + (lane & 15)) * dil + u.cls);
#pragma unroll
    for (int ks = 0; ks < 4; ++ks) qf[ks] = *(const bf16x8*)(Q + qrow * QKVW + gh * 128 + 32 * ks + 8 * (lane >> 4));
}
template <int NT>
__device__ __forceinline__ void attn_compute(const LAS unsigned char* Kl, const LAS unsigned char* Vl, const LAS float* biasP, const bf16x8 (&qf)[4], int kkb, int iq, int lane,
                                             bf16* orow, float* lsep, const f32x4 (&cv)[KVC_RIDE > 0 ? KVC_RIDE : 1], KArgs A, GAS float* outp, int cbase, int cgrp) {
    const int q = lane & 15, gq = lane >> 4;
    pg8::f32x4 st[NT];
    {
        bf16x8 kf[2][4];
#define ATT_LDK(buf, t_) do { const int kk_ = kkb + 16 * (t_) + q; \
            _Pragma("unroll") for (int ks_ = 0; ks_ < 4; ++ks_) kf[buf][ks_] = *(const LAS bf16x8*)(Kl + kk_ * 256 + (((4 * ks_ + gq) ^ (kk_ & 15)) << 4)); } while (0)
        ATT_LDK(0, 0);
#pragma unroll
        for (int t = 0; t < NT; ++t) {
            if (t + 1 < NT) ATT_LDK((t + 1) & 1, t + 1);
            __builtin_amdgcn_sched_barrier(0);
            st[t] = (pg8::f32x4){0.f, 0.f, 0.f, 0.f};
#pragma unroll
            for (int ks = 0; ks < 4; ++ks) st[t] = mfma16(kf[t & 1][ks], qf[ks], st[t]);
            __builtin_amdgcn_sched_barrier(0);
        }
#undef ATT_LDK
    }
    const LAS float* bp = biasP + (iq + 128 - kkb - 4 * gq + 160);
    float mx = -1e30f;
#pragma unroll
    for (int t = 0; t < NT; ++t)
#pragma unroll
        for (int r = 0; r < 4; ++r) { const float lg = st[t][r] + bp[-(16 * t + r)]; st[t][r] = lg; mx = fmaxf(mx, lg); }
    mx = fmaxf(mx, shfl_x(mx, 16, lane)); mx = fmaxf(mx, shfl_x(mx, 32, lane));
    float sum = 0.f;
#pragma unroll
    for (int t = 0; t < NT; ++t)
#pragma unroll
        for (int r = 0; r < 4; ++r) { const float p = __builtin_amdgcn_exp2f(st[t][r] - mx); st[t][r] = p; sum += p; }
    sum += shfl_x(sum, 16, lane); sum += shfl_x(sum, 32, lane);
    if (KVC_RIDE == 4) asm volatile("s_waitcnt vmcnt(4)" ::: "memory"); else if (KVC_RIDE == 6) asm volatile("s_waitcnt vmcnt(6)" ::: "memory"); else asm volatile("s_waitcnt vmcnt(0)" ::: "memory");
    __builtin_amdgcn_s_barrier(); asm volatile("" ::: "memory");
    pg8::f32x4 o[8];
#pragma unroll
    for (int dt = 0; dt < 8; ++dt) o[dt] = (pg8::f32x4){0.f, 0.f, 0.f, 0.f};
    {
        s16x4 vlo[2][4], vhi[2][4];
#define ATT_LDV(buf, h_) do { const int ra_ = kkb + 32 * ((h_) >> 1) + 4 * gq + (q >> 2); const LAS unsigned char* va_ = Vl + ra_ * 256 + (lane & 3) * 8; \
            _Pragma("unroll") for (int d_ = 0; d_ < 4; ++d_) { const int sw_ = ((4 * ((h_) & 1) + d_) ^ (ra_ & 7)) << 5; vlo[buf][d_] = tr16(va_ + sw_); vhi[buf][d_] = tr16(va_ + 16 * 256 + sw_); } } while (0)
        ATT_LDV(0, 0);
#pragma unroll
        for (int hs = 0; hs < NT; ++hs) {
            if (hs + 1 < NT) ATT_LDV((hs + 1) & 1, hs + 1);
            const int s = hs >> 1;
            const unsigned p0 = pk2(st[2 * s][0], st[2 * s][1]), p1 = pk2(st[2 * s][2], st[2 * s][3]), p2 = pk2(st[2 * s + 1][0], st[2 * s + 1][1]), p3 = pk2(st[2 * s + 1][2], st[2 * s + 1][3]);
            const bf16x8 pf = __builtin_bit_cast(bf16x8, (u32x4){p0, p1, p2, p3});
            __builtin_amdgcn_sched_barrier(0);
#pragma unroll
            for (int d = 0; d < 4; ++d) {
                const s16x4 lo = vlo[hs & 1][d], hi = vhi[hs & 1][d];
                const bf16x8 vf = (bf16x8){lo[0], lo[1], lo[2], lo[3], hi[0], hi[1], hi[2], hi[3]};
                o[4 * (hs & 1) + d] = mfma16(vf, pf, o[4 * (hs & 1) + d]);
            }
            __builtin_amdgcn_sched_barrier(0);
        }
#undef ATT_LDV
    }
    const float inv = 1.0f / sum;
#pragma unroll
    for (int dt = 0; dt < 8; ++dt) *(u32x2*)(orow + 16 * dt) = (u32x2){pk2(o[dt][0] * inv, o[dt][1] * inv), pk2(o[dt][2] * inv, o[dt][3] * inv)};
    if (gq == 0) *lsep = mx + __builtin_amdgcn_logf(sum);
#pragma unroll
    for (int j = 0; j < KVC_RIDE; ++j) { const f32x4* sp; f32x4* dp; kvc_map1(A, outp, cgrp, cbase + j * 512, sp, dp); __builtin_nontemporal_store(cv[j], dp); }
}
__device__ __forceinline__ void attn_phase(const Frame& F, int l) {
    const KArgs A = kargs();
    const int wave = F.wave;
    bf16* OG = (bf16*)(F.ws + WS_OG); float* LSE = (float*)(F.ws + WS_LSE);
    LAS unsigned char* Kl = F.lds; LAS unsigned char* Vl = F.lds + 65536; LAS float* biasP = (LAS float*)(F.lds + LDSBIAS_OFF);
    u32x4 kreg[8]; bf16x8 qn[4];
    if (F.vcu < 1536) { const AttnU u0 = attn_decode(F.vcu); attn_request(F, u0, F.tid, wave, kreg, qn); }
    const bool fixed_h = (F.G & 31) == 0;
    if (fixed_h) {
        const int h = F.vcu & 7;
        for (int e = F.tid; e < 3 * 448; e += 512) { const int g = e / 448, i = e - g * 448, du = i - 160, dil = g == 0 ? 1 : (g == 1 ? 4 : 16);
            biasP[e] = (du >= 0 && du <= 128) ? KIN(A, RELB)[t5_bucket(du * dil) * 24 + g * 8 + h] * LOG2E : -1e30f; }
    }
#pragma unroll 1
    for (int id = F.vcu; id < 1536; id += F.G) {
        int tid_ = F.tid; asm volatile("" : "+v"(tid_));
        const int tid = tid_, lane = tid & 63;
        const AttnU u = attn_decode(id);
        const int dil = u.g == 0 ? 1 : (u.g == 1 ? 4 : 16), gh = u.g * 8 + u.h, kk_lo = (u.n == 0) ? 128 : 0, npass = (256 - kk_lo) >> 5;
        {
            const int c16 = tid & 15, rr = tid >> 4;
            if (!fixed_h && tid < 448) { const int du = tid - 160; biasP[u.g * 448 + tid] = (du >= 0 && du <= 128) ? KIN(A, RELB)[t5_bucket(du * dil) * 24 + gh] * LOG2E : -1e30f; }
#pragma unroll
            for (int p = 0; p < 8; ++p) if (p < npass) {
                const int kk = kk_lo + 32 * p + rr;
                *(LAS u32x4*)(Kl + kk * 256 + ((c16 ^ (kk & 15)) << 4)) = kreg[p];
            }
        }
        bf16x8 qf[4];
#pragma unroll
        for (int ks = 0; ks < 4; ++ks) qf[ks] = qn[ks];
        {
            const bf16* V = (const bf16*)(F.ws + WS_V);
#pragma unroll
            for (int j = 0; j < 8; ++j) if (j < npass) {
                const int kk0 = kk_lo + 4 * (wave * npass + j), row = kk0 + (lane >> 4), sl = lane & 15, c16 = ((((sl >> 1) ^ (row & 7)) << 1) | (sl & 1));
                const bf16* gsrc = V + ((size_t)(u.b * TT + (128 * (u.n - 1) + row) * dil + u.cls)) * QKVW + gh * 128 + c16 * 8;
                __builtin_amdgcn_global_load_lds((const unsigned*)gsrc, (LAS unsigned*)(Vl + kk0 * 256), 16, 0, 0);
            }
        }
        asm volatile("s_waitcnt lgkmcnt(0)" ::: "memory"); __builtin_amdgcn_s_barrier(); asm volatile("" ::: "memory");
        if (id + F.G < 1536) { const AttnU un = attn_decode(id + F.G); attn_request(F, un, tid, wave, kreg, qn); }
        const int iq = 16 * wave + (lane & 15);
        const size_t qrow = (size_t)(u.b * TT + (128 * u.n + iq) * dil + u.cls);
        bf16* orow = OG + ((size_t)u.g * MPAD + qrow) * ATTW + u.h * 128 + 4 * (lane >> 4);
        float* lsep = LSE + ((size_t)u.g * MPAD + qrow) * 8 + u.h;
        f32x4 cv[KVC_RIDE > 0 ? KVC_RIDE : 1];
        const int cbase = l * KVC_LQ + KVC_LAYER + id * (512 * KVC_RIDE) + tid;
        const int cgrp = l == 0 ? 1 : 2;
        __builtin_amdgcn_sched_barrier(0);
#pragma unroll
        for (int j = 0; j < KVC_RIDE; ++j) { const f32x4* sp; f32x4* dp; kvc_map1(A, F.out, cgrp, cbase + j * 512, sp, dp); cv[j] = __builtin_nontemporal_load(sp); }
        __builtin_amdgcn_sched_barrier(0);
        if (u.n != 0) attn_compute<10>(Kl, Vl, biasP + u.g * 448, qf, 32 * (wave >> 1), iq, lane, orow, lsep, cv, A, F.out, cbase, cgrp);
        else attn_compute<8>(Kl, Vl, biasP + u.g * 448, qf, 128, iq, lane, orow, lsep, cv, A, F.out, cbase, cgrp);
        asm volatile("s_waitcnt lgkmcnt(0)" ::: "memory"); __builtin_amdgcn_s_barrier(); asm volatile("" ::: "memory");
    }
    __syncthreads();
}

__device__ __forceinline__ void attn_sample_task(const Frame& F, int l, int task) {
    const KArgs A = kargs();
    const float* relb = KIN(A, RELB);
    int lane_ = F.lane; asm volatile("" : "+v"(lane_));
    const int lane = lane_, s = task & 3, gh = (task >> 2) % 24, bs = task / 96, g = gh >> 3, h = gh & 7;
    const int dil = g == 0 ? 1 : (g == 1 ? 4 : 16), Wg = g == 0 ? 128 : (g == 1 ? 512 : 2048);
    const float* cache = (g == 0 ? KIN(A, C0) : (g == 1 ? KIN(A, C1) : KIN(A, C2))) + ((size_t)(l * NB_S + bs) * Wg) * KVROW + h * 128;
    const float* fresh = (const float*)F.out + (g == 0 ? O_KVS0 : (g == 1 ? O_KVS1 : O_KVS2)) + ((size_t)(l * NB_S + bs) * Wg) * KVROW + h * 128;
    const int row = MP + bs * 4 + s, hl = lane >> 5, d4 = (lane & 31) * 4;
    const bf16* Q = (const bf16*)(F.ws + WS_Q);
    const u32x2 qw = *(const u32x2*)(Q + (size_t)row * QKVW + gh * 128 + d4);
    const f32x4 q4 = (f32x4){bflo(qw.x), bfhi(qw.x), bflo(qw.y), bfhi(qw.y)};
    float mx = -1e30f, sum = 0.f; f32x4 acc = (f32x4){0.f, 0.f, 0.f, 0.f};
#pragma unroll 1
    for (int jb = 0; jb < 65; jb += 13) {
        f32x4 kv[13], vv[13]; float bsv[13];
#pragma unroll
        for (int u = 0; u < 13; ++u) {
            const int j = 2 * (jb + u) + hl, jc = j <= 128 ? j : 0, idx = Wg + s - jc * dil;
            const float* rowp = (idx < Wg ? cache + (size_t)idx * KVROW : fresh + (size_t)(idx - 4) * KVROW) + d4;
            kv[u] = *(const f32x4*)rowp; vv[u] = *(const f32x4*)(rowp + 1024); bsv[u] = relb[t5_bucket(jc * dil) * 24 + gh];
        }
        float lg[13], bm = -1e30f;
#pragma unroll
        for (int u = 0; u < 13; ++u) {
            const int j = 2 * (jb + u) + hl;
            float d = (kv[u][0] * q4[0] + kv[u][1] * q4[1]) + (kv[u][2] * q4[2] + kv[u][3] * q4[3]);
#pragma unroll
            for (int o = 1; o < 32; o <<= 1) d += shfl_x(d, o, lane);
            lg[u] = j <= 128 ? d + bsv[u] * LOG2E : -1e30f; bm = fmaxf(bm, lg[u]);
        }
        bm = fmaxf(bm, shfl_x(bm, 32, lane));
        const float mn = fmaxf(mx, bm), sc = __builtin_amdgcn_exp2f(mx - mn);
        acc = acc * sc; sum *= sc; mx = mn;
#pragma unroll
        for (int u = 0; u < 13; ++u) { const float p = __builtin_amdgcn_exp2f(lg[u] - mn); sum += p; acc += p * vv[u]; }
    }
    sum += shfl_x(sum, 32, lane);
#pragma unroll
    for (int e = 0; e < 4; ++e) acc[e] += shfl_x(acc[e], 32, lane);
    const float inv = 1.0f / sum;
    if (lane < 32) *(u32x2*)((bf16*)(F.ws + WS_OG) + ((size_t)g * MPAD + row) * ATTW + h * 128 + d4) = (u32x2){pk2(acc[0] * inv, acc[1] * inv), pk2(acc[2] * inv, acc[3] * inv)};
    if (lane == 0) ((float*)(F.ws + WS_LSE))[((size_t)g * MPAD + row) * 8 + h] = mx + __builtin_amdgcn_logf(sum);
}

__device__ __forceinline__ float one_minus_sq_exp(float x2, float a) {
    const float pser = -x2 * (1.0f + x2 * (0.5f + x2 * (0.16666667f + x2 * (0.041666668f + x2 * (0.0083333338f + x2 * 0.0013888889f)))));
    return x2 > -0.25f ? pser : 1.0f - a * a;
}
__device__ __forceinline__ void lru_unit(const Frame& F, int l, int b, int nb, int js, int uid) {
    const KArgs A = kargs();
    int tid_ = F.tid; asm volatile("" : "+v"(tid_));
    const int tid = tid_, lane = tid & 63, wave = F.wave, c0 = nb * 128, q = lane & 15, gq = lane >> 4;
    const bf16* XL = (const bf16*)(F.ws + WS_XL); const bf16* ZL = (const bf16*)(F.ws + WS_ZL); bf16* AL = (bf16*)(F.ws + WS_AL);
    LAS unsigned char* wl = F.lds + 65536;
    LAS float* wtot = (LAS float*)(F.lds + 65536 + 16384);
#pragma unroll
    for (int i = 0; i < 2; ++i) {
        const int ci = tid + 512 * i, dr = ci >> 4, ch = ci & 15;
        const bf16* src = (const bf16*)(F.ws + (dr < 32 ? WS_WR : WS_WI)) + ((size_t)(l * 16 + nb) * 128 + js * 32 + (dr & 31)) * 128 + 8 * ch;
        *(LAS u32x4*)(wl + dr * 256 + ((ch ^ (dr & 15)) << 4)) = *(const u32x4*)src;
    }
    float br[2], bi[2], sp8[2], carry[2];
#pragma unroll
    for (int cc = 0; cc < 2; ++cc) {
        const int ch = l * DM + c0 + js * 32 + 16 * cc + q;
        br[cc] = KIN(A, BR)[ch]; bi[cc] = KIN(A, BI)[ch]; sp8[cc] = 8.0f * log1pf(__expf(-KIN(A, LAM)[ch])); carry[cc] = 0.f;
    }
    const int tg = tid >> 4, chn = tid & 15;
    float cw[4][8], cb[8];
#pragma unroll
    for (int tap = 0; tap < 4; ++tap) { const f32x4 a = *(const f32x4*)(KIN(A, CONVW) + (size_t)(l * 4 + tap) * DM + c0 + 8 * chn), bq = *(const f32x4*)(KIN(A, CONVW) + (size_t)(l * 4 + tap) * DM + c0 + 8 * chn + 4);
        cw[tap][0] = a[0]; cw[tap][1] = a[1]; cw[tap][2] = a[2]; cw[tap][3] = a[3]; cw[tap][4] = bq[0]; cw[tap][5] = bq[1]; cw[tap][6] = bq[2]; cw[tap][7] = bq[3]; }
    { const f32x4 a = *(const f32x4*)(KIN(A, CONVB) + l * DM + c0 + 8 * chn), bq = *(const f32x4*)(KIN(A, CONVB) + l * DM + c0 + 8 * chn + 4);
      cb[0] = a[0]; cb[1] = a[1]; cb[2] = a[2]; cb[3] = a[3]; cb[4] = bq[0]; cb[5] = bq[1]; cb[6] = bq[2]; cb[7] = bq[3]; }
    u32x4 xw[7];
#define LRU_LOADX(ckk) do { _Pragma("unroll") for (int i = 0; i < 7; ++i) { const int t = (ckk) * 128 + 4 * tg - 3 + i; xw[i] = (u32x4){0u, 0u, 0u, 0u}; \
        if (t >= 0) xw[i] = *(const u32x4*)(XL + (size_t)(b * TT + t) * DM + c0 + 8 * chn); } } while (0)
    LRU_LOADX(0);
#pragma unroll 1
    for (int ck = 0; ck < 16; ++ck) {
        const int t0 = ck * 128;
        LAS unsigned char* xcL = F.lds + (ck & 1) * 32768;
        LAS float* wt = wtot + (ck & 1) * 512;
        {
            float x[7][8];
#pragma unroll
            for (int i = 0; i < 7; ++i) {
                const u32x4 w = xw[i];
                x[i][0] = bflo(w.x); x[i][1] = bfhi(w.x); x[i][2] = bflo(w.y); x[i][3] = bfhi(w.y); x[i][4] = bflo(w.z); x[i][5] = bfhi(w.z); x[i][6] = bflo(w.w); x[i][7] = bfhi(w.w);
            }
#pragma unroll
            for (int tt = 0; tt < 4; ++tt) {
                float y[8];
#pragma unroll
                for (int e = 0; e < 8; ++e) y[e] = cb[e] + ((cw[0][e] * x[tt][e] + cw[1][e] * x[tt + 1][e]) + (cw[2][e] * x[tt + 2][e] + cw[3][e] * x[tt + 3][e]));
                const int tok = 4 * tg + tt;
                *(LAS u32x4*)(xcL + tok * 256 + ((chn ^ (tok & 15)) << 4)) = (u32x4){pk2(y[0], y[1]), pk2(y[2], y[3]), pk2(y[4], y[5]), pk2(y[6], y[7])};
            }
        }
        __syncthreads();
        if (ck + 1 < 16) LRU_LOADX(ck + 1);
        f32x4 rv[KVC_LRIDE > 0 ? KVC_LRIDE : 1];
        const int rbase = l * KVC_LQ + KVC_LAYER + KVC_ATT + (uid * 16 + ck) * (512 * KVC_LRIDE) + tid, rgrp = l == 0 ? 1 : 2;
#pragma unroll
        for (int j = 0; j < KVC_LRIDE; ++j) { const f32x4* sp; f32x4* dp; kvc_map1(A, F.out, rgrp, rbase + j * 512, sp, dp); rv[j] = __builtin_nontemporal_load(sp); }
        bf16 zraw[2][4];
#pragma unroll
        for (int cc = 0; cc < 2; ++cc)
#pragma unroll
            for (int r = 0; r < 4; ++r) zraw[cc][r] = ZL[(size_t)(b * TT + t0 + 16 * wave + 4 * gq + r) * DM + c0 + js * 32 + 16 * cc + q];
        pg8::f32x4 acc[4];
        {
            const int tok = 16 * wave + q;
            bf16x8 af[4], bw[2][4];
#pragma unroll
            for (int ks = 0; ks < 4; ++ks) af[ks] = *(const LAS bf16x8*)(xcL + tok * 256 + (((4 * ks + gq) ^ (tok & 15)) << 4));
#pragma unroll
            for (int np = 0; np < 2; ++np) {
#pragma unroll
                for (int j = 0; j < 2; ++j)
#pragma unroll
                    for (int ks = 0; ks < 4; ++ks) bw[j][ks] = *(const LAS bf16x8*)(wl + (32 * np + 16 * j + q) * 256 + (((4 * ks + gq) ^ q) << 4));
                __builtin_amdgcn_sched_barrier(0);
#pragma unroll
                for (int j = 0; j < 2; ++j) { acc[2 * np + j] = (pg8::f32x4){0.f, 0.f, 0.f, 0.f};
#pragma unroll
                    for (int ks = 0; ks < 4; ++ks) acc[2 * np + j] = mfma16(af[ks], bw[j][ks], acc[2 * np + j]); }
                __builtin_amdgcn_sched_barrier(0);
            }
        }
        float pp[2][4], sv[2][4], Pex[2], Sex[2];
#pragma unroll
        for (int cc = 0; cc < 2; ++cc) {
            const int cidx = js * 32 + 16 * cc + q;
            float a[4], u[4];
#pragma unroll
            for (int r = 0; r < 4; ++r) {
                const int tok = 16 * wave + 4 * gq + r;
                const float xv = bf1(*(const LAS bf16*)(xcL + tok * 256 + (((cidx >> 3) ^ (tok & 15)) << 4) + (cidx & 7) * 2));
                const float rg = sigm(acc[cc][r] + br[cc]), ig = sigm(acc[2 + cc][r] + bi[cc]);
                const float la = -sp8[cc] * rg;
                a[r] = __expf(la); u[r] = __builtin_amdgcn_sqrtf(one_minus_sq_exp(2.0f * la, a[r])) * (ig * xv);
            }
            pp[cc][0] = a[0]; sv[cc][0] = u[0];
#pragma unroll
            for (int r = 1; r < 4; ++r) { pp[cc][r] = pp[cc][r - 1] * a[r]; sv[cc][r] = a[r] * sv[cc][r - 1] + u[r]; }
            float P = pp[cc][3], S = sv[cc][3];
            { const float Pn = shfl_u(P, 16, lane), Sn = shfl_u(S, 16, lane); if (gq >= 1) { S = P * Sn + S; P = P * Pn; } }
            { const float Pn = shfl_u(P, 32, lane), Sn = shfl_u(S, 32, lane); if (gq >= 2) { S = P * Sn + S; P = P * Pn; } }
            { const float Pn = shfl_u(P, 16, lane), Sn = shfl_u(S, 16, lane); Pex[cc] = gq >= 1 ? Pn : 1.0f; Sex[cc] = gq >= 1 ? Sn : 0.0f; }
            if (gq == 3) { wt[(wave * 2 + cc) * 32 + 2 * q] = P; wt[(wave * 2 + cc) * 32 + 2 * q + 1] = S; }
        }
        __syncthreads();
#pragma unroll
        for (int cc = 0; cc < 2; ++cc) {
            float hin = carry[cc], hall = carry[cc];
#pragma unroll
            for (int w = 0; w < 8; ++w) {
                const float P = wt[(w * 2 + cc) * 32 + 2 * q], S = wt[(w * 2 + cc) * 32 + 2 * q + 1];
                hall = P * hall + S; if (w < wave) hin = hall;
            }
            carry[cc] = hall;
            const float hl = Pex[cc] * hin + Sex[cc];
            const int ch = c0 + js * 32 + 16 * cc + q;
#pragma unroll
            for (int r = 0; r < 4; ++r) {
                const float hv = pp[cc][r] * hl + sv[cc][r];
                const size_t ro = (size_t)(b * TT + t0 + 16 * wave + 4 * gq + r) * DM + ch;
                AL[ro] = (bf16)(pk2(hv * bf1(zraw[cc][r]), 0.f) & 0xffffu);
                if (ck == 15 && wave == 7 && gq == 3 && r == 3) F.out[O_HP + (size_t)(l * NB_P + b) * DM + ch] = hv;
            }
        }
#pragma unroll
        for (int j = 0; j < KVC_LRIDE; ++j) { const f32x4* sp; f32x4* dp; kvc_map1(A, F.out, rgrp, rbase + j * 512, sp, dp); __builtin_nontemporal_store(rv[j], dp); }
    }
#undef LRU_LOADX
    __syncthreads();
}
__device__ __forceinline__ void lru_sample_unit(const Frame& F, int l, int bs, int nb, int dq) {
    const KArgs A = kargs();
    int tid_ = F.tid; asm volatile("" : "+v"(tid_));
    const int tid = tid_, lane = tid & 63, c0 = nb * 128;
    LAS float* xc = (LAS float*)F.lds;
    const bf16* XL = (const bf16*)(F.ws + WS_XL);
    {
        const int t = tid >> 7, c = tid & 127;
        float y = KIN(A, CONVB)[l * DM + c0 + c];
#pragma unroll
        for (int tap = 0; tap < 4; ++tap) {
            const int p = t + tap;
            const float xv = p < 3 ? KIN(A, SCONV)[((size_t)(l * NB_S + bs) * 3 + p) * DM + c0 + c] : bf1(XL[(size_t)(MP + bs * 4 + (p - 3)) * DM + c0 + c]);
            y += KIN(A, CONVW)[(size_t)(l * 4 + tap) * DM + c0 + c] * xv;
        }
        xc[t * 128 + c] = y;
    }
    const int cq = tid & 3, t = (tid >> 2) & 3, d = dq * 32 + (tid >> 4), chg = l * DM + c0 + d;
    const bf16* wr = (const bf16*)(F.ws + WS_WR) + ((size_t)(l * 16 + nb) * 128 + d) * 128 + 32 * cq;
    const bf16* wi = (const bf16*)(F.ws + WS_WI) + ((size_t)(l * 16 + nb) * 128 + d) * 128 + 32 * cq;
    u32x4 wrv[4], wiv[4];
#pragma unroll
    for (int i = 0; i < 4; ++i) { wrv[i] = *(const u32x4*)(wr + 8 * i); wiv[i] = *(const u32x4*)(wi + 8 * i); }
    const float brv = KIN(A, BR)[chg], biv = KIN(A, BI)[chg], sp8 = 8.0f * log1pf(__expf(-KIN(A, LAM)[chg]));
    const float h0 = KIN(A, SH)[(size_t)(l * NB_S + bs) * DM + c0 + d];
    const size_t ro = (size_t)(MP + bs * 4 + t) * DM + c0 + d;
    const float zv = bf1(((const bf16*)(F.ws + WS_ZL))[ro]);
    __syncthreads();
    float rp = 0.f, ip = 0.f;
#pragma unroll
    for (int i = 0; i < 4; ++i) {
        const f32x4 xa = *(const LAS f32x4*)(xc + t * 128 + 32 * cq + 8 * i), xb = *(const LAS f32x4*)(xc + t * 128 + 32 * cq + 8 * i + 4);
        rp += (xa[0] * bflo(wrv[i].x) + xa[1] * bfhi(wrv[i].x)) + (xa[2] * bflo(wrv[i].y) + xa[3] * bfhi(wrv[i].y)) + (xb[0] * bflo(wrv[i].z) + xb[1] * bfhi(wrv[i].z)) + (xb[2] * bflo(wrv[i].w) + xb[3] * bfhi(wrv[i].w));
        ip += (xa[0] * bflo(wiv[i].x) + xa[1] * bfhi(wiv[i].x)) + (xa[2] * bflo(wiv[i].y) + xa[3] * bfhi(wiv[i].y)) + (xb[0] * bflo(wiv[i].z) + xb[1] * bfhi(wiv[i].z)) + (xb[2] * bflo(wiv[i].w) + xb[3] * bfhi(wiv[i].w));
    }
    rp += shfl_x(rp, 1, lane); rp += shfl_x(rp, 2, lane); ip += shfl_x(ip, 1, lane); ip += shfl_x(ip, 2, lane);
    const float rg = sigm(rp + brv), ig = sigm(ip + biv), la = -sp8 * rg;
    float P = __expf(la), S = __builtin_amdgcn_sqrtf(one_minus_sq_exp(2.0f * la, P)) * (ig * xc[t * 128 + d]);
    { const float Pn = shfl_u(P, 4, lane), Sn = shfl_u(S, 4, lane); if (t >= 1) { S = P * Sn + S; P = P * Pn; } }
    { const float Pn = shfl_u(P, 8, lane), Sn = shfl_u(S, 8, lane); if (t >= 2) { S = P * Sn + S; P = P * Pn; } }
    const float hv = P * h0 + S;
    if (cq == 0) {
        ((bf16*)(F.ws + WS_AL))[ro] = (bf16)(pk2(hv * zv, 0.f) & 0xffffu);
        if (t == 3) F.out[O_HS + (size_t)(l * NB_S + bs) * DM + c0 + d] = hv;
    }
    __syncthreads();
}
#ifndef PROBE_SUB
#define PROBE_SUB 0
#endif
__device__ __forceinline__ void phase_mix(const Frame& F, int l) {
#pragma unroll 1
    for (int rep = 0; rep < (PROBE_SUB == 1 ? 2 : 1); ++rep) attn_phase(F, l);
#pragma unroll 1
    for (int rep = 0; rep < (PROBE_SUB == 2 ? 2 : 1); ++rep)
#pragma unroll 1
        for (int id = F.vcu; id < 256; id += F.G) lru_unit(F, l, id >> 6, (id >> 2) & 15, id & 3, id);
#pragma unroll 1
    for (int rep = 0; rep < (PROBE_SUB == 3 ? 2 : 1); ++rep) {
#pragma unroll 1
        for (int id = F.vcu; id < 512; id += F.G) lru_sample_unit(F, l, id >> 6, (id >> 2) & 15, id & 3);
        if (F.wave < 3) { for (int task = F.vcu * 3 + F.wave; task < 768; task += F.G * 3) attn_sample_task(F, l, task); }
        else kvcopy_range(F, l * KVC_LQ, l * KVC_LQ + KVC_LAYER, (F.vcu * 5 + (F.wave - 3)) * 64 + F.lane, F.G * 320);
        __syncthreads();
    }
}
typedef float f32x16 __attribute__((ext_vector_type(16)));
typedef float f32x2v __attribute__((ext_vector_type(2)));
template <int K, int LD, int NB, class Epi>
__device__ __forceinline__ void thin_gemm(const Frame& F, const bf16* A, const bf16* Bt, int N, const Epi& E) {
    int tid_ = F.tid; asm volatile("" : "+v"(tid_));
    const int tid = tid_, lane = tid & 63, wave = F.wave, r32 = lane & 31, hh = lane >> 5;
    constexpr int KS = K / 8, KB = NB == 1 ? 8 : 4, NBAT = KS / (16 * KB);
    LAS float* part = (LAS float*)F.lds;
#pragma unroll 1
    for (int item = F.vcu; item < N / (32 * NB); item += F.G) {
        const int n0 = item * 32 * NB;
        const bf16* ap = A + (size_t)r32 * LD + wave * KS + 8 * hh;
        const bf16* bp = Bt + (size_t)(n0 + r32) * LD + wave * KS + 8 * hh;
        f32x16 acc[NB];
#pragma unroll
        for (int b = 0; b < NB; ++b)
#pragma unroll
            for (int i = 0; i < 16; ++i) acc[b][i] = 0.f;
        bf16x8 af[2][KB], bf[2][NB][KB];
#define THIN_LD(buf, h2_) do { _Pragma("unroll") for (int ks_ = 0; ks_ < KB; ++ks_) { af[buf][ks_] = *(const bf16x8*)(ap + ((h2_) * KB + ks_) * 16); \
            _Pragma("unroll") for (int b_ = 0; b_ < NB; ++b_) bf[buf][b_][ks_] = *(const bf16x8*)(bp + (size_t)b_ * 32 * LD + ((h2_) * KB + ks_) * 16); } } while (0)
        THIN_LD(0, 0);
#pragma unroll
        for (int h2 = 0; h2 < NBAT; ++h2) {
            if (h2 + 1 < NBAT) THIN_LD((h2 + 1) & 1, h2 + 1);
#pragma unroll
            for (int ks = 0; ks < KB; ++ks)
#pragma unroll
                for (int b = 0; b < NB; ++b) acc[b] = __builtin_amdgcn_mfma_f32_32x32x16_bf16(af[h2 & 1][ks], bf[h2 & 1][b][ks], acc[b], 0, 0, 0);
        }
#undef THIN_LD
#pragma unroll
        for (int b = 0; b < NB; ++b)
#pragma unroll
            for (int reg = 0; reg < 16; ++reg) part[((wave * NB + b) * 32 + (reg & 3) + 8 * (reg >> 2) + 4 * hh) * 32 + r32] = acc[b][reg];
        __syncthreads();
        const int row = tid >> 4, c2 = (tid & 15) * 2;
#pragma unroll
        for (int b = 0; b < NB; ++b) {
            float v0 = 0.f, v1 = 0.f;
#pragma unroll
            for (int w = 0; w < 8; ++w) { const f32x2v pv = *(const LAS f32x2v*)(part + ((w * NB + b) * 32 + row) * 32 + c2); v0 += pv[0]; v1 += pv[1]; }
            E(row, n0 + b * 32 + c2, v0, v1);
        }
        __syncthreads();
    }
}
struct ThinIn {
    bf16 *Q, *K, *V, *ZA, *XL, *ZL, *GA, *GL; GAS float* out; int l;
    __device__ __forceinline__ void operator()(int r, int c, float v0, float v1) const {
        const size_t row = MP + r; const int bs = r >> 2, s = r & 3;
        if (c < C_K) { *(unsigned*)(Q + row * QKVW + c) = pk2(v0 * QSCALE, v1 * QSCALE); }
        else if (c < C_ZA) {
            const int which = c < C_V ? 1 : 2, cc = c - which * QKVW, gi = cc >> 10, Wg = gi == 0 ? 128 : (gi == 1 ? 512 : 2048);
            *(unsigned*)((which == 1 ? K : V) + row * QKVW + cc) = pk2(v0, v1);
            GAS float* dst = out + (gi == 0 ? O_KVS0 : (gi == 1 ? O_KVS1 : O_KVS2)) + (((size_t)(l * NB_S + bs) * Wg + (Wg - 4 + s)) * 2 + (which - 1)) * 1024 + (cc & 1023);
            dst[0] = v0; dst[1] = v1;
        }
        else if (c < C_XL) { *(unsigned*)(ZA + row * ATTW + (c - C_ZA)) = pk2(v0 * sigm(v0), v1 * sigm(v1)); }
        else if (c < C_ZL) {
            *(unsigned*)(XL + row * DM + (c - C_XL)) = pk2(v0, v1);
            if (s >= 1) { GAS float* dst = out + O_CVS + ((size_t)(l * NB_S + bs) * 3 + (s - 1)) * DM + (c - C_XL); dst[0] = v0; dst[1] = v1; }
        }
        else if (c < C_GA) { *(unsigned*)(ZL + row * DM + (c - C_ZL)) = pk2(v0 * sigm(v0), v1 * sigm(v1)); }
        else if (c < C_GL) { *(unsigned*)(GA + row * DM + (c - C_GA)) = pk2(sigm(v0), sigm(v1)); }
        else { *(unsigned*)(GL + row * DM + (c - C_GL)) = pk2(sigm(v0), sigm(v1)); }
    }
};
struct ThinPA { const bf16* GA; bf16* TMP;
    __device__ __forceinline__ void operator()(int r, int c, float v0, float v1) const { const size_t o = (size_t)(MP + r) * DM + c; const unsigned g = *(const unsigned*)(GA + o); *(unsigned*)(TMP + o) = pk2(v0 * bflo(g), v1 * bfhi(g)); } };
struct ThinPB { const bf16* GL; const bf16* TMP; bf16* MG;
    __device__ __forceinline__ void operator()(int r, int c, float v0, float v1) const { const size_t o = (size_t)(MP + r) * DM + c; const unsigned g = *(const unsigned*)(GL + o), tw = *(const unsigned*)(TMP + o); *(unsigned*)(MG + o) = pk2(bflo(tw) + v0 * bflo(g), bfhi(tw) + v1 * bfhi(g)); } };
struct ThinOut { const float* xs; float* X; const float* mod; int l;
    __device__ __forceinline__ void operator()(int r, int c, float v0, float v1) const {
        const size_t o = (size_t)(MP + r) * DM + c; const float* gp = mod + (size_t)(l * NMODB + NB_P + (r >> 2)) * 6144 + 4096 + c;
        const float x0 = l == 0 ? xs[(size_t)r * DM + c] : X[o], x1 = l == 0 ? xs[(size_t)r * DM + c + 1] : X[o + 1];
        X[o] = x0 + gp[0] * v0; X[o + 1] = x1 + gp[1] * v1; } };
struct MergeRow { float l0, l1, l2; u32x4 a[2], b[2], c[2], z[2]; };
__device__ __forceinline__ void merge_load(const Frame& F, int r, int lane, MergeRow& m) {
    const bf16* OG = (const bf16*)(F.ws + WS_OG); const float* LSE = (const float*)(F.ws + WS_LSE); const bf16* ZA = (const bf16*)(F.ws + WS_ZA);
    const int h = lane >> 3;
    m.l0 = LSE[((size_t)0 * MPAD + r) * 8 + h]; m.l1 = LSE[((size_t)1 * MPAD + r) * 8 + h]; m.l2 = LSE[((size_t)2 * MPAD + r) * 8 + h];
#pragma unroll
    for (int hf = 0; hf < 2; ++hf) {
        const size_t co = (size_t)r * ATTW + lane * 16 + hf * 8;
        m.a[hf] = *(const u32x4*)(OG + co); m.b[hf] = *(const u32x4*)(OG + (size_t)MPAD * ATTW + co); m.c[hf] = *(const u32x4*)(OG + (size_t)2 * MPAD * ATTW + co); m.z[hf] = *(const u32x4*)(ZA + co);
    }
}
__device__ __forceinline__ void merge_store(const Frame& F, int r, int lane, const MergeRow& m) {
    bf16* AA = (bf16*)(F.ws + WS_AA);
    const float mx = fmaxf(m.l0, fmaxf(m.l1, m.l2));
    float w0 = __builtin_amdgcn_exp2f(m.l0 - mx), w1 = __builtin_amdgcn_exp2f(m.l1 - mx), w2 = __builtin_amdgcn_exp2f(m.l2 - mx);
    const float inv = __builtin_amdgcn_rcpf(w0 + w1 + w2); w0 *= inv; w1 *= inv; w2 *= inv;
#pragma unroll
    for (int hf = 0; hf < 2; ++hf) {
        u32x4 o;
#pragma unroll
        for (int e = 0; e < 4; ++e) {
            const float lo = (w0 * bflo(m.a[hf][e]) + w1 * bflo(m.b[hf][e]) + w2 * bflo(m.c[hf][e])) * bflo(m.z[hf][e]);
            const float hi = (w0 * bfhi(m.a[hf][e]) + w1 * bfhi(m.b[hf][e]) + w2 * bfhi(m.c[hf][e])) * bfhi(m.z[hf][e]);
            o[e] = pk2(lo, hi);
        }
        *(u32x4*)(AA + (size_t)r * DM + lane * 16 + hf * 8) = o;
    }
}
__device__ __forceinline__ void phase_merge(const Frame& F) {
    const int gw = F.vcu * 8 + F.wave, NGW = F.G * 8, lane = F.lane;
#pragma unroll 1
    for (int r0 = 4 * gw; r0 < MR; r0 += 4 * NGW) {
        const int nrow = (MR - r0) < 4 ? (MR - r0) : 4;
        MergeRow cur, nxt;
        merge_load(F, r0, lane, cur);
#pragma unroll
        for (int k = 0; k < 4; ++k) if (k < nrow) {
            if (k + 1 < nrow) merge_load(F, r0 + k + 1, lane, nxt);
            merge_store(F, r0 + k, lane, cur);
            cur = nxt;
        }
    }
}

#ifndef MK_PER_PHASE
#define MK_PER_PHASE 0
#endif
constexpr int N_PHASES = 2 + 6 * DEPTH + 1;

__global__ void __launch_bounds__(512, 2) fwd_kernel(Args args) {
    extern __shared__ __attribute__((aligned(16))) unsigned char lds_raw[];
    Frame F0;
    F0.lds = (LAS unsigned char*)lds_raw;
    F0.tid = threadIdx.x; F0.lane = F0.tid & 63; F0.wave = __builtin_amdgcn_readfirstlane(F0.tid >> 6);
    F0.G = gridDim.x; { const int bx = blockIdx.x; F0.vcu = (F0.G % 8 == 0) ? (bx % 8) * (F0.G / 8) + bx / 8 : bx; }
    F0.out = (GAS float*)args.out; F0.ws = (GAS unsigned char*)args.ws;
    for (int u = F0.tid; u < 128; u += 512) ((LAS unsigned*)(F0.lds + LDSCTL_OFF))[u] = 0u;
    __syncthreads();
    unsigned* ctl = (unsigned*)(args.ws + WS_CTL);
    XcdBarrier bar = xcd_barrier_post(ctl + CW_BAR + args.li * XCD_BAR_WORDS, (volatile LAS unsigned*)(F0.lds + LDSCTL_OFF) + 8);
    const int lo = args.ph_lo, hi = args.ph_hi;
#define IN(k) (lo <= (k) && (k) < hi)
#define IS_T0() (F0.wave == 0 && hw_lane() == 0)
#ifndef PROBE_XBAR
#define PROBE_XBAR 1
#endif
#define SEAM(k) do { if (IN(k) && IN((k) + 1)) { for (int xb_ = 0; xb_ < PROBE_XBAR; ++xb_) xcd_barrier(bar, IS_T0()); } } while (0)
#ifndef PROBE_REP
#define PROBE_REP (-1)
#endif
#ifndef PROBE_N
#define PROBE_N 1
#endif
#define REPEAT(kind, ...) do { __VA_ARGS__ if (PROBE_REP == (kind)) { for (int rep_ = 0; rep_ < PROBE_N; ++rep_) { xcd_barrier(bar, IS_T0()); __VA_ARGS__ } } } while (0)

    #ifndef NO_P0
    if (IN(0)) REPEAT(0, { const Frame F = fresh(F0); p0_prologue(F); });
#endif
    SEAM(0);
    #ifndef NO_P1
    if (IN(1)) { const Frame F = fresh(F0); p1_modreduce(F); }
#endif
    SEAM(1);
#pragma unroll 1
    for (int l = 0; l < DEPTH; ++l) {
        const int pb = 2 + 6 * l;
#ifndef NO_PA
        if (IN(pb)) REPEAT(2, { const Frame F = fresh(F0); phase_norm(F, l); });
#endif
        SEAM(pb);
#ifndef NO_PB
        if (IN(pb + 1)) REPEAT(3, {
            const Frame F = fresh(F0);
            pg8::Gemm g{(const pg8::bf16_t*)(F.ws + WS_H), (const pg8::bf16_t*)(F.ws + WS_WIN) + (size_t)l * INC * DM, MP, INC, DM};
            pg8::StaticOrder S; S.init(MP, INC, F.G, (int)blockIdx.x);
            EpiIn E{(bf16*)(F.ws + WS_Q), (bf16*)(F.ws + WS_K), (bf16*)(F.ws + WS_V), (bf16*)(F.ws + WS_ZA), (bf16*)(F.ws + WS_XL), (bf16*)(F.ws + WS_ZL), (bf16*)(F.ws + WS_GA), (bf16*)(F.ws + WS_GL), F.out, l};
            pg8::gemm_phase<EpiIn, pg8::StaticOrder, true, true>(F.lds, g, S, E, F.tid);
            ThinIn TE{E.Q, E.K, E.V, E.ZA, E.XL, E.ZL, E.GA, E.GL, F.out, l};
            thin_gemm<DM, DM, 3, ThinIn>(F, (const bf16*)(F.ws + WS_H) + (size_t)MP * DM, (const bf16*)(F.ws + WS_WIN) + (size_t)l * INC * DM, INC, TE);
        });
#endif
        SEAM(pb + 1);
#ifndef NO_PC
        if (IN(pb + 2)) REPEAT(4, { const Frame F = fresh(F0); phase_mix(F, l); });
#endif
        SEAM(pb + 2);
#ifndef NO_PC2
        if (IN(pb + 3)) REPEAT(5, { const Frame F = fresh(F0); phase_merge(F); });
#endif
        SEAM(pb + 3);
#ifndef NO_PD
        if (IN(pb + 4)) REPEAT(6, {
            const Frame F = fresh(F0);
            {
                pg8::Gemm g0{(const pg8::bf16_t*)(F.ws + WS_AA), (const pg8::bf16_t*)(F.ws + WS_WPA) + (size_t)l * DM * DM, MP, DM, ATTW};
                pg8::Gemm g1{(const pg8::bf16_t*)(F.ws + WS_AL), (const pg8::bf16_t*)(F.ws + WS_WPB) + (size_t)l * DM * DM, MP, DM, DM};
                pg8::StaticOrder S; S.init(MP, DM, F.G, (int)blockIdx.x);
                EpiMerge E{(const bf16*)(F.ws + WS_GA), (const bf16*)(F.ws + WS_GL), (bf16*)(F.ws + WS_MG)};
                pg8::gemm_chain<EpiMerge, pg8::StaticOrder>(F.lds, g0, g1, DM, S, E, F.tid);
            }
            {
                ThinPA TE{(const bf16*)(F.ws + WS_GA), (bf16*)(F.ws + WS_TMP)};
                thin_gemm<ATTW, DM, 1, ThinPA>(F, (const bf16*)(F.ws + WS_AA) + (size_t)MP * DM, (const bf16*)(F.ws + WS_WPA) + (size_t)l * DM * DM, DM, TE);
                ThinPB TB{(const bf16*)(F.ws + WS_GL), (const bf16*)(F.ws + WS_TMP), (bf16*)(F.ws + WS_MG)};
                thin_gemm<DM, DM, 1, ThinPB>(F, (const bf16*)(F.ws + WS_AL) + (size_t)MP * DM, (const bf16*)(F.ws + WS_WPB) + (size_t)l * DM * DM, DM, TB);
            }
        });
#endif
        SEAM(pb + 4);
#ifndef NO_PE
        if (IN(pb + 5)) {
            const Frame F = fresh(F0);
            pg8::Gemm g{(const pg8::bf16_t*)(F.ws + WS_MG), (const pg8::bf16_t*)(F.ws + WS_WOUT) + (size_t)l * DM * DM, MP, DM, DM};
            pg8::StaticOrder S; S.init(MP, DM, F.G, (int)blockIdx.x);
            const KArgs A = kargs();
            EpiOut E{KIN(A, XP), KIN(A, XS), (float*)(F.ws + WS_X), (const float*)(F.ws + WS_MOD), l};
            pg8::gemm_phase<EpiOut, pg8::StaticOrder, false, true>(F.lds, g, S, E, F.tid);
            ThinOut TE{E.xs, E.X, E.mod, l};
            thin_gemm<DM, DM, 1, ThinOut>(F, (const bf16*)(F.ws + WS_MG) + (size_t)MP * DM, (const bf16*)(F.ws + WS_WOUT) + (size_t)l * DM * DM, DM, TE);
        }
#endif
        SEAM(pb + 5);
    }
#ifndef NO_PF
    { int lo2 = lo, hi2 = hi; asm volatile("" : "+s"(lo2), "+s"(hi2));
      if (lo2 <= N_PHASES - 1 && N_PHASES - 1 < hi2) { const Frame F = fresh(F0); phase_final(F); } }
#endif
#undef IN
#undef SEAM
}

extern "C" void kernel_launch(void* const* d_in, const int* in_sizes, int n_in, void* d_out, int out_size, void* d_ws, size_t ws_size, hipStream_t stream) {
    static int grid = 0;
    if (grid == 0) {
        if (n_in != 25 || (size_t)out_size != O_END || ws_size < WS_END) { fprintf(stderr, "kernel_launch: built for 25 inputs, %zu outputs, >= %zu bytes of workspace; got n_in %d, out %d, ws %zu; nothing launched\n", (size_t)O_END, (size_t)WS_END, n_in, out_size, ws_size); grid = -1; return; }
        int dev = 0, cus = 0, per_cu = 0;
        if (hipGetDevice(&dev) != hipSuccess || hipDeviceGetAttribute(&cus, hipDeviceAttributeMultiprocessorCount, dev) != hipSuccess) { fprintf(stderr, "kernel_launch: device query failed\n"); grid = -1; return; }
        if (hipFuncSetAttribute((const void*)fwd_kernel, hipFuncAttributeMaxDynamicSharedMemorySize, LDS_BYTES) != hipSuccess) { fprintf(stderr, "kernel_launch: hipFuncSetAttribute failed\n"); grid = -1; return; }
        if (hipOccupancyMaxActiveBlocksPerMultiprocessor(&per_cu, (const void*)fwd_kernel, 512, LDS_BYTES) != hipSuccess || per_cu < 1) fprintf(stderr, "kernel_launch: note: occupancy query reports %d workgroups per CU\n", per_cu);
        (void)hipGetLastError();
        grid = cus;
    }
    if (grid < 0) return;
    if (hipMemsetAsync((char*)d_ws + WS_CTL, 0, CTL_ZERO_BYTES, stream) != hipSuccess) { fprintf(stderr, "kernel_launch: hipMemsetAsync failed\n"); return; }
    Args a{};
    for (int i = 0; i < 25; ++i) a.in[i] = (const float*)d_in[i];
    a.out = (float*)d_out; a.ws = (unsigned char*)d_ws;
#if MK_PER_PHASE
    for (int p = 0; p < N_PHASES; ++p) { a.ph_lo = p; a.ph_hi = p + 1; a.li = p; a.pad = 0; hipLaunchKernelGGL(fwd_kernel, dim3(grid), dim3(512), LDS_BYTES, stream, a); }
#else
    a.ph_lo = 0; a.ph_hi = N_PHASES; a.li = 0; a.pad = 0;
    hipLaunchKernelGGL(fwd_kernel, dim3(grid), dim3(512), LDS_BYTES, stream, a);
#endif
    const hipError_t le = hipPeekAtLastError();
    if (le != hipSuccess) fprintf(stderr, "kernel_launch: launch failed: %s\n", hipGetErrorName(le));
}
```

```cpp
#include <hip/hip_runtime.h>
#include <cstdio>
#include <cstdint>
namespace pg8 {
#define PG8_LAS __attribute__((address_space(3)))
typedef unsigned short bf16_t;
typedef short bf16x8 __attribute__((ext_vector_type(8)));
typedef float f32x4 __attribute__((ext_vector_type(4)));
typedef unsigned u32x4 __attribute__((ext_vector_type(4)));
constexpr int BM = 256, BK = 64, HALF = 128, HTB = HALF * BK * 2  , STAGE_BYTES = 8 * HTB, NXCD = 8, WGM = 8;

__host__ __device__ __forceinline__ int lds_byte(int r, int c) { const int st = (r >> 4) * 2 + (c >> 5), rr = r & 15, cc = c & 31, ob = rr * 64 + cc * 2; return st * 1024 + (ob ^ (((ob >> 9) & 1) << 5)); }
__host__ __device__ __forceinline__ void stage_rc(int b, int& R, int& C) { const int st = b / 1024, sb = b % 1024, swz = sb ^ (((sb >> 9) & 1) << 5); R = (st >> 1) * 16 + swz / 64; C = (st & 1) * 32 + (swz % 64) / 2; }
__host__ __device__ __forceinline__ int perm32(int rho) { const int n = rho >> 4, i = rho & 15; return 8 * (i >> 2) + 4 * n + (i & 3); }

struct Unit { int pm, pn; };
struct Gemm { const bf16_t* A; const bf16_t* Bt; int M, N, K; };

struct StaticOrder {
    int nM, nN, nwg, G, c;
    __host__ __device__ void init(int M, int N, int G_, int c_) { nM = M / BM; nN = N / BM; nwg = nM * nN; G = G_; c = c_; }
    __host__ __device__ bool next(int i, Unit& u) const {
        const long L = (long)i * G + c; if (L >= nwg) return false;
        int wgid = (int)L; { const int q = nwg / NXCD, r = nwg % NXCD, xcd = wgid % NXCD, off = wgid / NXCD; wgid = (xcd < r ? xcd * (q + 1) : r * (q + 1) + (xcd - r) * q) + off; }
        const int nig = WGM * nN, gid = wgid / nig, fm = gid * WGM, gsz = (nM - fm) < WGM ? (nM - fm) : WGM;
        u.pm = fm + ((wgid % nig) % gsz); u.pn = (wgid % nig) / gsz; return true;
    }
    __device__ __forceinline__ void a_ready(const Unit&) const {}
    __device__ __forceinline__ void done(const Unit&) const {}
};

__device__ __forceinline__ unsigned cvt_pk_bf16(float lo, float hi) { unsigned r; asm volatile("v_cvt_pk_bf16_f32 %0, %1, %2" : "=v"(r) : "v"(lo), "v"(hi)); return r; }
typedef float f32x2 __attribute__((ext_vector_type(2)));
template <class Epi, class Sched, bool ALIGN_EPI = false, bool SP2 = false>
__device__ __forceinline__ void gemm_phase(PG8_LAS unsigned char* lds, const Gemm g, const Sched& S, const Epi& E, int tid_in) {
    int tid_ = tid_in; asm volatile("" : "+v"(tid_));
    const int tid = tid_, wid = __builtin_amdgcn_readfirstlane(tid >> 6), lane = tid & 63, wr = wid >> 2, wc = wid & 3, fr = lane & 15, fq = lane >> 4;
    const int K = g.K, nt = K / BK;
    unsigned voffA[2], voffB[2];
#pragma unroll
    for (int i = 0; i < 2; ++i) { int R, C; stage_rc(tid * 16 + i * 8192, R, C); const int Rb = Epi::PERM ? ((R & ~31) + perm32(R & 31)) : R;
        voffA[i] = (unsigned)(R * K + C) * 2u; voffB[i] = (unsigned)(Rb * K + C) * 2u; }
    const size_t kstep = (size_t)(BK * 2);
    const size_t hstep = (size_t)HALF * K * 2;
    const size_t tstep = 2 * hstep;
    const unsigned ldsw = (unsigned)wid * 1024u;
    const int aoff = lds_byte(wr * 64 + fr, fq * 8), boff = lds_byte(wc * 32 + fr, fq * 8);
#define PG8_SA(b, h) (((b) * 2 + (h)) * HTB)
#define PG8_SB(b, h) ((4 + (b) * 2 + (h)) * HTB)
#define PG8_STAGE(bufoff, gbase, voff) do { _Pragma("unroll") for (int _i = 0; _i < 2; ++_i) \
        __builtin_amdgcn_global_load_lds((const unsigned*)((const char*)(gbase) + (voff)[_i]), (PG8_LAS unsigned*)(lds + (bufoff) + ldsw + _i * 8192), 16, 0, 0); } while (0)
#define PG8_LDA(dst, b, h) do { _Pragma("unroll") for (int m = 0; m < 4; ++m) _Pragma("unroll") for (int k = 0; k < 2; ++k) dst[m][k] = *(const PG8_LAS bf16x8*)(lds + PG8_SA(b, h) + aoff + m * 2048 + k * 1024); } while (0)
#define PG8_LDB(dst, b, h) do { _Pragma("unroll") for (int n = 0; n < 2; ++n) _Pragma("unroll") for (int k = 0; k < 2; ++k) dst[n][k] = *(const PG8_LAS bf16x8*)(lds + PG8_SB(b, h) + boff + n * 2048 + k * 1024); } while (0)
#define PG8_MMA(ai, bj, At, Bt) do { __builtin_amdgcn_s_setprio(1); _Pragma("unroll") for (int m = 0; m < 4; ++m) _Pragma("unroll") for (int n = 0; n < 2; ++n) _Pragma("unroll") for (int k = 0; k < 2; ++k) \
        acc[ai][bj][m][n] = __builtin_amdgcn_mfma_f32_16x16x32_bf16(Bt[n][k], At[m][k], acc[ai][bj][m][n], 0, 0, 0); __builtin_amdgcn_s_setprio(0); } while (0)
#define PG8_WAIT_V(n) asm volatile("s_waitcnt vmcnt(" #n ")" ::: "memory")
#define PG8_WAIT_VSEL(n, steady_) asm volatile("s_waitcnt vmcnt(%0)\n\ts_cmp_eq_u32 %1, 0\n\ts_cbranch_scc1 .Lpg8w%=\n\ts_waitcnt vmcnt(8)\n.Lpg8w%=:" :: "n"(n), "s"(steady_) : "memory", "scc")
#define PG8_WAIT_L(n) asm volatile("s_waitcnt lgkmcnt(" #n ")" ::: "memory")
#define PG8_BAR __builtin_amdgcn_s_barrier()
#define PG8_SCHED __builtin_amdgcn_sched_barrier(0)
    Unit cur, nxt; int ui = 0;
    if (!S.next(0, cur)) return;
    __builtin_amdgcn_s_waitcnt(0x0F70);
    f32x4 acc[2][2][4][2];
#pragma unroll
    for (int a = 0; a < 2; ++a)
#pragma unroll
        for (int b = 0; b < 2; ++b)
#pragma unroll
            for (int m = 0; m < 4; ++m)
#pragma unroll
                for (int n = 0; n < 2; ++n) acc[a][b][m][n] = (f32x4){0.f, 0.f, 0.f, 0.f};
    bf16x8 At[4][2], B0[2][2], B1[2][2];
    const char* cA = (const char*)g.A + (size_t)cur.pm * tstep; const char* cB = (const char*)g.Bt + (size_t)cur.pn * tstep;
    S.a_ready(cur);
    if constexpr (SP2) {
        PG8_STAGE(PG8_SB(0, 0), cB, voffB); PG8_STAGE(PG8_SB(0, 1), cB + hstep, voffB); PG8_STAGE(PG8_SA(0, 0), cA, voffA); PG8_STAGE(PG8_SA(0, 1), cA + hstep, voffA);
        if (wr == 1) PG8_BAR;
        PG8_WAIT_V(2); PG8_BAR;
        PG8_STAGE(PG8_SB(1, 0), cB + kstep, voffB); PG8_STAGE(PG8_SA(1, 0), cA + kstep, voffA); PG8_STAGE(PG8_SB(1, 1), cB + hstep + kstep, voffB);
        PG8_WAIT_V(6); PG8_BAR;
    } else {
        PG8_STAGE(PG8_SB(0, 0), cB, voffB); PG8_STAGE(PG8_SA(0, 0), cA, voffA); PG8_STAGE(PG8_SB(0, 1), cB + hstep, voffB); PG8_STAGE(PG8_SA(0, 1), cA + hstep, voffA);
        if (wr == 1) PG8_BAR;
        PG8_WAIT_V(4); PG8_BAR;
        PG8_STAGE(PG8_SB(1, 0), cB + kstep, voffB); PG8_STAGE(PG8_SA(1, 0), cA + kstep, voffA); PG8_STAGE(PG8_SB(1, 1), cB + hstep + kstep, voffB);
        PG8_WAIT_V(6); PG8_BAR;
    }
    for (;;) {
        const bool has_next = S.next(ui + 1, nxt);
        const char* nA = has_next ? (const char*)g.A + (size_t)nxt.pm * tstep : cA; const char* nB = has_next ? (const char*)g.Bt + (size_t)nxt.pn * tstep : cB;
        for (int t = 0; t < nt; t += 2) {
            const bool last = (t == nt - 2);
            const char* a1 = cA + (size_t)(t + 1) * kstep;
            const char* a2 = last ? nA : cA + (size_t)(t + 2) * kstep; const char* b2 = last ? nB : cB + (size_t)(t + 2) * kstep;
            const char* a3 = a2 + kstep; const char* b3 = b2 + kstep;
            if (last && has_next) S.a_ready(nxt);
            if constexpr (SP2) {
            const int steady = __builtin_amdgcn_readfirstlane((Epi::MIN_STORES > 0 && t == 0 && ui > 0) ? 0 : 1);
            PG8_LDB(B0, 0, 0); PG8_LDB(B1, 0, 1); PG8_SCHED; PG8_LDA(At, 0, 0); PG8_STAGE(PG8_SA(1, 1), a1 + hstep, voffA);
            if constexpr (Epi::MIN_STORES > 0) PG8_WAIT_VSEL(8 + Epi::MIN_STORES, steady); else PG8_WAIT_V(8);
            PG8_WAIT_L(0); PG8_BAR; PG8_MMA(0, 0, At, B0); PG8_MMA(0, 1, At, B1); PG8_BAR; PG8_SCHED;
            PG8_LDA(At, 0, 1); PG8_STAGE(PG8_SB(0, 0), b2, voffB); PG8_STAGE(PG8_SB(0, 1), b2 + hstep, voffB); PG8_STAGE(PG8_SA(0, 0), a2, voffA);
            if constexpr (Epi::MIN_STORES > 0) PG8_WAIT_VSEL(8 + Epi::MIN_STORES, steady); else PG8_WAIT_V(8);
            PG8_WAIT_L(0); PG8_BAR; PG8_MMA(1, 0, At, B0); PG8_MMA(1, 1, At, B1); PG8_BAR; PG8_SCHED;
            PG8_LDB(B0, 1, 0); PG8_LDB(B1, 1, 1); PG8_SCHED; PG8_LDA(At, 1, 0); PG8_STAGE(PG8_SA(0, 1), a2 + hstep, voffA);
            PG8_WAIT_V(8); PG8_WAIT_L(0); PG8_BAR; PG8_MMA(0, 0, At, B0); PG8_MMA(0, 1, At, B1); PG8_BAR; PG8_SCHED;
            PG8_LDA(At, 1, 1); PG8_STAGE(PG8_SB(1, 0), b3, voffB); PG8_STAGE(PG8_SB(1, 1), b3 + hstep, voffB); PG8_STAGE(PG8_SA(1, 0), a3, voffA);
            PG8_WAIT_V(8); PG8_WAIT_L(0); PG8_BAR; PG8_MMA(1, 0, At, B0); PG8_MMA(1, 1, At, B1); PG8_BAR; PG8_SCHED;
            } else {
            PG8_LDB(B0, 0, 0); PG8_SCHED; PG8_LDA(At, 0, 0); PG8_STAGE(PG8_SA(1, 1), a1 + hstep, voffA);
            PG8_WAIT_L(8); PG8_BAR; PG8_WAIT_L(0); PG8_MMA(0, 0, At, B0); PG8_BAR; PG8_SCHED;
            PG8_LDB(B1, 0, 1); PG8_STAGE(PG8_SB(0, 0), b2, voffB);
            PG8_BAR; PG8_WAIT_L(0); PG8_MMA(0, 1, At, B1); PG8_BAR;
            PG8_LDA(At, 0, 1); PG8_STAGE(PG8_SA(0, 0), a2, voffA);
            PG8_BAR; PG8_WAIT_L(0); PG8_MMA(1, 0, At, B0); PG8_BAR; PG8_SCHED;
            PG8_STAGE(PG8_SB(0, 1), b2 + hstep, voffB);
            PG8_WAIT_V(6); PG8_BAR; PG8_MMA(1, 1, At, B1); PG8_BAR;
            PG8_LDB(B0, 1, 0); PG8_SCHED; PG8_LDA(At, 1, 0); PG8_STAGE(PG8_SA(0, 1), a2 + hstep, voffA);
            PG8_WAIT_L(8); PG8_BAR; PG8_WAIT_L(0); PG8_MMA(0, 0, At, B0); PG8_BAR; PG8_SCHED;
            PG8_LDB(B1, 1, 1); PG8_STAGE(PG8_SB(1, 0), b3, voffB);
            PG8_BAR; PG8_WAIT_L(0); PG8_MMA(0, 1, At, B1); PG8_BAR;
            PG8_LDA(At, 1, 1); PG8_STAGE(PG8_SA(1, 0), a3, voffA);
            PG8_BAR; PG8_WAIT_L(0); PG8_MMA(1, 0, At, B0); PG8_BAR; PG8_SCHED;
            PG8_STAGE(PG8_SB(1, 1), b3 + hstep, voffB);
            PG8_WAIT_V(6); PG8_BAR; PG8_MMA(1, 1, At, B1); PG8_BAR;
            }
        }
        if constexpr (ALIGN_EPI) { if (wr == 0) PG8_BAR; }
#ifdef TPROBE
#ifndef TPROBE_ALLEPI
#define TPROBE_ALLEPI 0
#endif
        if constexpr (Epi::MIN_STORES > 0 || TPROBE_ALLEPI) {
            const unsigned tp0 = (unsigned)__builtin_amdgcn_s_memrealtime();
            E(acc, cur, wr, wc, fr, fq);
            asm volatile("" ::: "memory");
            const unsigned tp1 = (unsigned)__builtin_amdgcn_s_memrealtime();
            if (tid == 0) __hip_atomic_fetch_add((PG8_LAS unsigned*)(lds + STAGE_BYTES) + 100, tp1 - tp0, __ATOMIC_RELAXED, __HIP_MEMORY_SCOPE_WORKGROUP);
        } else
#endif
        if constexpr (!Epi::AFTER_DRAIN) { E(acc, cur, wr, wc, fr, fq); S.done(cur); }
        if (!has_next) break;
#pragma unroll
        for (int a = 0; a < 2; ++a)
#pragma unroll
            for (int b = 0; b < 2; ++b)
#pragma unroll
                for (int m = 0; m < 4; ++m)
#pragma unroll
                    for (int n = 0; n < 2; ++n) acc[a][b][m][n] = (f32x4){0.f, 0.f, 0.f, 0.f};
        cur = nxt; cA = nA; cB = nB; ++ui;
        if constexpr (ALIGN_EPI) { if (wr == 1) PG8_BAR; }
    }
    PG8_WAIT_V(0);
    if constexpr (!ALIGN_EPI) { if (wr == 0) PG8_BAR; }
    PG8_BAR;
    if constexpr (Epi::AFTER_DRAIN) { E.fused(acc, cur, wr, wc, fr, fq, lds, wid, lane); S.done(cur); }
#undef PG8_SA
#undef PG8_SB
#undef PG8_STAGE
#undef PG8_LDA
#undef PG8_LDB
#undef PG8_MMA
#undef PG8_WAIT_V
#undef PG8_WAIT_VSEL
#undef PG8_WAIT_L
#undef PG8_BAR
#undef PG8_SCHED
}
template <class Epi, class Sched>
__device__ __forceinline__ void gemm_chain(PG8_LAS unsigned char* lds, const Gemm g0, const Gemm g1, int ld, const Sched& S, const Epi& E, int tid_in) {
    int tid_ = tid_in; asm volatile("" : "+v"(tid_));
    const int tid = tid_, wid = __builtin_amdgcn_readfirstlane(tid >> 6), lane = tid & 63, wr = wid >> 2, wc = wid & 3, fr = lane & 15, fq = lane >> 4;
    const int K0 = g0.K, K1 = g1.K;
    unsigned voffA[2], voffB[2];
#pragma unroll
    for (int i = 0; i < 2; ++i) { int R, C; stage_rc(tid * 16 + i * 8192, R, C); const int Rb = Epi::PERM ? ((R & ~31) + perm32(R & 31)) : R;
        voffA[i] = (unsigned)(R * ld + C) * 2u; voffB[i] = (unsigned)(Rb * ld + C) * 2u; }
    const size_t kstep = (size_t)(BK * 2);
    const size_t hstep = (size_t)HALF * ld * 2, tstep = 2 * hstep;
    const unsigned ldsw = (unsigned)wid * 1024u;
    const int aoff = lds_byte(wr * 64 + fr, fq * 8), boff = lds_byte(wc * 32 + fr, fq * 8);
#define PG8_SA(b, h) (((b) * 2 + (h)) * HTB)
#define PG8_SB(b, h) ((4 + (b) * 2 + (h)) * HTB)
#define PG8_STAGE(bufoff, gbase, voff) do { _Pragma("unroll") for (int _i = 0; _i < 2; ++_i) \
        __builtin_amdgcn_global_load_lds((const unsigned*)((const char*)(gbase) + (voff)[_i]), (PG8_LAS unsigned*)(lds + (bufoff) + ldsw + _i * 8192), 16, 0, 0); } while (0)
#define PG8_LDA(dst, b, h) do { _Pragma("unroll") for (int m = 0; m < 4; ++m) _Pragma("unroll") for (int k = 0; k < 2; ++k) dst[m][k] = *(const PG8_LAS bf16x8*)(lds + PG8_SA(b, h) + aoff + m * 2048 + k * 1024); } while (0)
#define PG8_LDB(dst, b, h) do { _Pragma("unroll") for (int n = 0; n < 2; ++n) _Pragma("unroll") for (int k = 0; k < 2; ++k) dst[n][k] = *(const PG8_LAS bf16x8*)(lds + PG8_SB(b, h) + boff + n * 2048 + k * 1024); } while (0)
#define PG8_MMA(ai, bj, At, Bt) do { __builtin_amdgcn_s_setprio(1); _Pragma("unroll") for (int m = 0; m < 4; ++m) _Pragma("unroll") for (int n = 0; n < 2; ++n) _Pragma("unroll") for (int k = 0; k < 2; ++k) \
        acc[ai][bj][m][n] = __builtin_amdgcn_mfma_f32_16x16x32_bf16(Bt[n][k], At[m][k], acc[ai][bj][m][n], 0, 0, 0); __builtin_amdgcn_s_setprio(0); } while (0)
#define PG8_WAIT_V(n) asm volatile("s_waitcnt vmcnt(" #n ")" ::: "memory")
#define PG8_WAIT_L(n) asm volatile("s_waitcnt lgkmcnt(" #n ")" ::: "memory")
#define PG8_BAR __builtin_amdgcn_s_barrier()
#define PG8_SCHED __builtin_amdgcn_sched_barrier(0)
    Unit cur, nxt; int ui = 0;
    if (!S.next(0, cur)) return;
    f32x4 acc[2][2][4][2];
#pragma unroll
    for (int a = 0; a < 2; ++a)
#pragma unroll
        for (int b = 0; b < 2; ++b)
#pragma unroll
            for (int m = 0; m < 4; ++m)
#pragma unroll
                for (int n = 0; n < 2; ++n) acc[a][b][m][n] = (f32x4){0.f, 0.f, 0.f, 0.f};
    bf16x8 At[4][2], B0[2][2], B1[2][2];
    const char* cA = (const char*)g0.A + (size_t)cur.pm * tstep; const char* cB = (const char*)g0.Bt + (size_t)cur.pn * tstep;
    PG8_STAGE(PG8_SB(0, 0), cB, voffB); PG8_STAGE(PG8_SB(0, 1), cB + hstep, voffB); PG8_STAGE(PG8_SA(0, 0), cA, voffA); PG8_STAGE(PG8_SA(0, 1), cA + hstep, voffA);
    if (wr == 1) PG8_BAR;
    PG8_WAIT_V(2); PG8_BAR;
    PG8_STAGE(PG8_SB(1, 0), cB + kstep, voffB); PG8_STAGE(PG8_SA(1, 0), cA + kstep, voffA); PG8_STAGE(PG8_SB(1, 1), cB + hstep + kstep, voffB);
    PG8_WAIT_V(6); PG8_BAR;
#define PG8_KSTREAM(NT_, CA_, CB_, NA_, NB_) do { const int nt_ = (NT_); \
        for (int t = 0; t < nt_; t += 2) { \
            const bool last = (t == nt_ - 2); \
            const char* a1 = (CA_) + (size_t)(t + 1) * kstep; \
            const char* a2 = last ? (NA_) : (CA_) + (size_t)(t + 2) * kstep; const char* b2 = last ? (NB_) : (CB_) + (size_t)(t + 2) * kstep; \
            const char* a3 = a2 + kstep; const char* b3 = b2 + kstep; \
            PG8_LDB(B0, 0, 0); PG8_LDB(B1, 0, 1); PG8_SCHED; PG8_LDA(At, 0, 0); PG8_STAGE(PG8_SA(1, 1), a1 + hstep, voffA); \
            PG8_WAIT_V(8); PG8_WAIT_L(0); PG8_BAR; PG8_MMA(0, 0, At, B0); PG8_MMA(0, 1, At, B1); PG8_BAR; PG8_SCHED; \
            PG8_LDA(At, 0, 1); PG8_STAGE(PG8_SB(0, 0), b2, voffB); PG8_STAGE(PG8_SB(0, 1), b2 + hstep, voffB); PG8_STAGE(PG8_SA(0, 0), a2, voffA); \
            PG8_WAIT_V(8); PG8_WAIT_L(0); PG8_BAR; PG8_MMA(1, 0, At, B0); PG8_MMA(1, 1, At, B1); PG8_BAR; PG8_SCHED; \
            PG8_LDB(B0, 1, 0); PG8_LDB(B1, 1, 1); PG8_SCHED; PG8_LDA(At, 1, 0); PG8_STAGE(PG8_SA(0, 1), a2 + hstep, voffA); \
            PG8_WAIT_V(8); PG8_WAIT_L(0); PG8_BAR; PG8_MMA(0, 0, At, B0); PG8_MMA(0, 1, At, B1); PG8_BAR; PG8_SCHED; \
            PG8_LDA(At, 1, 1); PG8_STAGE(PG8_SB(1, 0), b3, voffB); PG8_STAGE(PG8_SB(1, 1), b3 + hstep, voffB); PG8_STAGE(PG8_SA(1, 0), a3, voffA); \
            PG8_WAIT_V(8); PG8_WAIT_L(0); PG8_BAR; PG8_MMA(1, 0, At, B0); PG8_MMA(1, 1, At, B1); PG8_BAR; PG8_SCHED; \
        } } while (0)
    for (;;) {
        const char* mA = (const char*)g1.A + (size_t)cur.pm * tstep; const char* mB = (const char*)g1.Bt + (size_t)cur.pn * tstep;
        PG8_KSTREAM(K0 / BK, cA, cB, mA, mB);
        E.mid(acc, cur, wr, wc, fr, fq);
        const bool has_tile = S.next(ui + 1, nxt);
        const char* nA = has_tile ? (const char*)g0.A + (size_t)nxt.pm * tstep : mA; const char* nB = has_tile ? (const char*)g0.Bt + (size_t)nxt.pn * tstep : mB;
        PG8_KSTREAM(K1 / BK, mA, mB, nA, nB);
        E(acc, cur, wr, wc, fr, fq);
        if (!has_tile) break;
#pragma unroll
        for (int a = 0; a < 2; ++a)
#pragma unroll
            for (int b = 0; b < 2; ++b)
#pragma unroll
                for (int m = 0; m < 4; ++m)
#pragma unroll
                    for (int n = 0; n < 2; ++n) acc[a][b][m][n] = (f32x4){0.f, 0.f, 0.f, 0.f};
        cur = nxt; cA = nA; cB = nB; ++ui;
    }
#undef PG8_KSTREAM
    PG8_WAIT_V(0);
    if (wr == 0) PG8_BAR;
    PG8_BAR;
#undef PG8_SA
#undef PG8_SB
#undef PG8_STAGE
#undef PG8_LDA
#undef PG8_LDB
#undef PG8_MMA
#undef PG8_WAIT_V
#undef PG8_WAIT_L
#undef PG8_BAR
#undef PG8_SCHED
}
}

#define GAS __attribute__((address_space(1)))
#define LAS __attribute__((address_space(3)))
typedef unsigned short bf16;
typedef unsigned u32x4 __attribute__((ext_vector_type(4)));
typedef unsigned u32x2 __attribute__((ext_vector_type(2)));
typedef float f32x4 __attribute__((ext_vector_type(4)));
typedef short bf16x8 __attribute__((ext_vector_type(8)));
typedef short s16x4 __attribute__((ext_vector_type(4)));

constexpr int DM = 2048, NB_P = 4, TT = 2048, DEPTH = 4, NB_S = 8, TS = 4;
constexpr int MP = NB_P * TT;
constexpr int MS = NB_S * TS;
constexpr int MR = MP + MS;
constexpr int MPAD = 8448;
constexpr int QKVW = 3072, ATTW = 1024, INC = 18432;
constexpr int C_K = 3072, C_V = 6144, C_ZA = 9216, C_XL = 10240, C_ZL = 12288, C_GA = 14336, C_GL = 16384;
constexpr int NMODB = 12;
constexpr float RMS_EPS = 1e-6f;
constexpr float LOG2E = 1.4426950408889634f;
constexpr float QSCALE = 0.08838834764831845f * 1.4426950408889634f;

constexpr size_t KVROW = 2048;
constexpr size_t O_YP = 0;
constexpr size_t O_YS = O_YP + (size_t)MP * DM;
constexpr size_t O_KVP0 = O_YS + (size_t)MS * DM;
constexpr size_t O_KVP1 = O_KVP0 + (size_t)DEPTH * NB_P * 128 * KVROW;
constexpr size_t O_KVP2 = O_KVP1 + (size_t)DEPTH * NB_P * 512 * KVROW;
constexpr size_t O_CVP = O_KVP2 + (size_t)DEPTH * NB_P * 2048 * KVROW;
constexpr size_t O_HP = O_CVP + (size_t)DEPTH * NB_P * 3 * DM;
constexpr size_t O_KVS0 = O_HP + (size_t)DEPTH * NB_P * DM;
constexpr size_t O_KVS1 = O_KVS0 + (size_t)DEPTH * NB_S * 128 * KVROW;
constexpr size_t O_KVS2 = O_KVS1 + (size_t)DEPTH * NB_S * 512 * KVROW;
constexpr size_t O_CVS = O_KVS2 + (size_t)DEPTH * NB_S * 2048 * KVROW;
constexpr size_t O_HS = O_CVS + (size_t)DEPTH * NB_S * 3 * DM;
constexpr size_t O_END = O_HS + (size_t)DEPTH * NB_S * DM;
static_assert(O_END == 281477120ull, "d_out size");

constexpr size_t MiB = 1u << 20;
constexpr size_t al1(size_t x) { return (x + MiB - 1) / MiB * MiB; }
constexpr size_t WS_CTL = 0, CTL_ZERO_BYTES = 1 * MiB;
constexpr size_t WS_WIN = 1 * MiB;
constexpr size_t WS_WPA = WS_WIN + al1((size_t)DEPTH * INC * DM * 2);
constexpr size_t WS_WPB = WS_WPA + al1((size_t)DEPTH * DM * DM * 2);
constexpr size_t WS_WOUT = WS_WPB + al1((size_t)DEPTH * DM * DM * 2);
constexpr size_t WS_WR = WS_WOUT + al1((size_t)DEPTH * DM * DM * 2);
constexpr size_t WS_WI = WS_WR + al1((size_t)DEPTH * 16 * 128 * 128 * 2);
constexpr size_t WS_MODP = WS_WI + al1((size_t)DEPTH * 16 * 128 * 128 * 2);
constexpr size_t WS_MOD = WS_MODP + al1((size_t)DEPTH * 16 * NMODB * 6144 * 4);
constexpr size_t WS_H = WS_MOD + al1((size_t)DEPTH * NMODB * 6144 * 4);
constexpr size_t WS_Q = WS_H + al1((size_t)MPAD * DM * 2);
constexpr size_t WS_K = WS_Q + al1((size_t)MPAD * QKVW * 2);
constexpr size_t WS_V = WS_K + al1((size_t)MPAD * QKVW * 2);
constexpr size_t WS_ZA = WS_V + al1((size_t)MPAD * QKVW * 2);
constexpr size_t WS_XL = WS_ZA + al1((size_t)MPAD * ATTW * 2);
constexpr size_t WS_ZL = WS_XL + al1((size_t)MPAD * DM * 2);
constexpr size_t WS_GA = WS_ZL + al1((size_t)MPAD * DM * 2);
constexpr size_t WS_GL = WS_GA + al1((size_t)MPAD * DM * 2);
constexpr size_t WS_OG = WS_GL + al1((size_t)MPAD * DM * 2);
constexpr size_t WS_LSE = WS_OG + al1((size_t)3 * MPAD * ATTW * 2);
constexpr size_t WS_AA = WS_LSE + al1((size_t)3 * MPAD * 8 * 4);
constexpr size_t WS_AL = WS_AA + al1((size_t)MPAD * DM * 2);
constexpr size_t WS_TMP = WS_AL + al1((size_t)MPAD * DM * 2);
constexpr size_t WS_MG = WS_TMP + al1((size_t)MPAD * DM * 4);
constexpr size_t WS_X = WS_MG + al1((size_t)MPAD * DM * 2);
constexpr size_t WS_END = WS_X + al1((size_t)MPAD * DM * 4);
constexpr int CW_P0Q = 256;
constexpr int CW_BAR = 4096;

constexpr int RING_BYTES = 131072;
constexpr int LDSCTL_OFF = RING_BYTES;
constexpr int LDSBIAS_OFF = RING_BYTES + 512;
constexpr int LDS_BYTES = 147456;

#define LDS_WAIT() asm volatile("s_waitcnt lgkmcnt(0)" ::: "memory")
#define VM_WAIT() asm volatile("s_waitcnt vmcnt(0)" ::: "memory")

__device__ __forceinline__ unsigned pk2(float lo, float hi) { return pg8::cvt_pk_bf16(lo, hi); }
__device__ __forceinline__ float bflo(unsigned w) { return __uint_as_float(w << 16); }
__device__ __forceinline__ float bfhi(unsigned w) { return __uint_as_float(w & 0xffff0000u); }
__device__ __forceinline__ float bf1(bf16 v) { return __uint_as_float(((unsigned)v) << 16); }
__device__ __forceinline__ float sigm(float v) { return __builtin_amdgcn_rcpf(1.0f + __expf(-v)); }
__device__ __forceinline__ float shfl_x(float v, int m, int lane) { return __builtin_bit_cast(float, __builtin_amdgcn_ds_bpermute((lane ^ m) << 2, __builtin_bit_cast(int, v))); }
__device__ __forceinline__ float shfl_u(float v, int d, int lane) { const int src = lane - d; return __builtin_bit_cast(float, __builtin_amdgcn_ds_bpermute((src < 0 ? lane : src) << 2, __builtin_bit_cast(int, v))); }
__device__ __forceinline__ float wave_sum(float v, int lane) {
#pragma unroll
    for (int o = 1; o < 64; o <<= 1) v += shfl_x(v, o, lane);
    return v;
}
__device__ __forceinline__ float wave_max(float v, int lane) {
#pragma unroll
    for (int o = 1; o < 64; o <<= 1) v = fmaxf(v, shfl_x(v, o, lane));
    return v;
}
__device__ __forceinline__ int t5_bucket(int d) {
    if (d < 16) return d;
    int b = 16;
    b += (d >= 22); b += (d >= 30); b += (d >= 40); b += (d >= 54); b += (d >= 73); b += (d >= 99); b += (d >= 134); b += (d >= 182);
    b += (d >= 246); b += (d >= 332); b += (d >= 450); b += (d >= 609); b += (d >= 825); b += (d >= 1117); b += (d >= 1513);
    return b;
}

__device__ __forceinline__ int hw_lane() { int l; asm volatile("v_mbcnt_lo_u32_b32 %0, -1, 0\n\tv_mbcnt_hi_u32_b32 %0, -1, %0" : "=v"(l)); return l; }
struct Args { const float* in[25]; float* out; unsigned char* ws; int ph_lo, ph_hi, li, pad; };
enum InIdx { I_XP = 0, I_XS, I_CP, I_CS, I_C0, I_C1, I_C2, I_SCONV, I_SH, I_RELB, I_WADA, I_BADA, I_NORMG, I_WIN, I_CONVW, I_CONVB, I_WR, I_BR, I_WI, I_BI, I_LAM, I_WPA, I_WPB, I_WOUT, I_FING };

struct Frame {
    LAS unsigned char* lds;
    int tid, lane, wave, vcu, G;
    GAS float* out; GAS unsigned char* ws;
};
typedef const __attribute__((address_space(4))) Args* KArgs;
__device__ __forceinline__ KArgs kargs() { KArgs p = (KArgs)__builtin_amdgcn_kernarg_segment_ptr(); asm volatile("" : "+s"(p)); return p; }
#define KIN(A, NAME) ((const float*)(const GAS float*)(A)->in[I_##NAME])
__device__ __forceinline__ Frame fresh(const Frame& F0) {
    Frame F = F0; int lane = hw_lane();
    asm volatile("" : "+v"(lane), "+s"(F.ws), "+s"(F.out), "+s"(F.vcu), "+s"(F.wave), "+s"(F.G)); F.lane = lane; F.tid = F.wave * 64 + lane; return F; }


constexpr int KVC_S0 = (128 - 4) * 512, KVC_S1 = (512 - 4) * 512, KVC_S2 = (2048 - 4) * 512;
constexpr int KVC_C1 = DEPTH * NB_S * KVC_S0, KVC_C2 = KVC_C1 + DEPTH * NB_S * KVC_S1, KVC_TOTAL = KVC_C2 + DEPTH * NB_S * KVC_S2;
constexpr int KVC_RIDE = 4;
constexpr int KVC_LRIDE = 1;
constexpr int KVC_LQ = KVC_TOTAL / 4, KVC_LAYER = 2191872, KVC_ATT = 1536 * 512 * KVC_RIDE, KVC_LRU = 256 * 16 * 512 * KVC_LRIDE, KVC_REM = KVC_LQ - KVC_LAYER - KVC_ATT - KVC_LRU;
static_assert(KVC_TOTAL % 4 == 0 && KVC_REM >= 0, "copy partition");
static_assert(KVC_LAYER >= KVC_C1 && KVC_LAYER + KVC_ATT + KVC_LRU <= KVC_C2 && KVC_LQ + KVC_LAYER >= KVC_C2 && KVC_LAYER % 512 == 0, "riding ranges vs. group boundaries");
__device__ __forceinline__ void kvc_map(KArgs A, GAS float* out, int i, const f32x4*& sp, f32x4*& dp) {
    int j = i, W, S; const f32x4* sb; GAS f32x4* db;
    if (j < KVC_C1) { W = 128; S = KVC_S0; sb = (const f32x4*)KIN(A, C0); db = (GAS f32x4*)(out + O_KVS0); }
    else if (j < KVC_C2) { j -= KVC_C1; W = 512; S = KVC_S1; sb = (const f32x4*)KIN(A, C1); db = (GAS f32x4*)(out + O_KVS1); }
    else { j -= KVC_C2; W = 2048; S = KVC_S2; sb = (const f32x4*)KIN(A, C2); db = (GAS f32x4*)(out + O_KVS2); }
    const int sg = j / S, of = j - sg * S; const size_t o = (size_t)sg * W * 512 + of; sp = sb + o + 2048; dp = (f32x4*)(db + o);
}
__device__ __forceinline__ void kvc_map1(KArgs A, GAS float* out, int grp, int i, const f32x4*& sp, f32x4*& dp) {
    const int W = grp == 0 ? 128 : (grp == 1 ? 512 : 2048), S = grp == 0 ? KVC_S0 : (grp == 1 ? KVC_S1 : KVC_S2), j = i - (grp == 0 ? 0 : (grp == 1 ? KVC_C1 : KVC_C2));
    const f32x4* sb = (const f32x4*)(grp == 0 ? KIN(A, C0) : (grp == 1 ? KIN(A, C1) : KIN(A, C2)));
    GAS f32x4* db = (GAS f32x4*)(out + (grp == 0 ? O_KVS0 : (grp == 1 ? O_KVS1 : O_KVS2)));
    const int sg = j / S, of = j - sg * S; const size_t o = (size_t)sg * W * 512 + of; sp = sb + o + 2048; dp = (f32x4*)(db + o);
}
__device__ __forceinline__ void kvcopy_range(const Frame& F, int i0, int i1, int tix, int nth) {
    const KArgs A = kargs();
    int i = i0 + tix;
#pragma unroll 1
    for (; i + 15 * nth < i1; i += 16 * nth) {
        f32x4 v[16]; f32x4* dp[16];
#pragma unroll
        for (int j = 0; j < 16; ++j) { const f32x4* sp; kvc_map(A, F.out, i + j * nth, sp, dp[j]); v[j] = __builtin_nontemporal_load(sp); }
#pragma unroll
        for (int j = 0; j < 16; ++j) __builtin_nontemporal_store(v[j], dp[j]);
    }
#pragma unroll 1
    for (; i < i1; i += nth) { const f32x4* sp; f32x4* dp; kvc_map(A, F.out, i, sp, dp); __builtin_nontemporal_store(__builtin_nontemporal_load(sp), dp); }
}
struct BgCopy4 {
    f32x4 v[4]; f32x4* dp[4];
    __device__ __forceinline__ void request(GAS float* out, int start, int tid) {
        const KArgs A = kargs();
#pragma unroll
        for (int j = 0; j < 4; ++j) { const f32x4* sp; kvc_map(A, out, start + j * 512 + tid, sp, dp[j]); v[j] = __builtin_nontemporal_load(sp); }
        asm volatile("" ::: "memory");
    }
    __device__ __forceinline__ void finish() {
        asm volatile("" ::: "memory");
#pragma unroll
        for (int j = 0; j < 4; ++j) __builtin_nontemporal_store(v[j], dp[j]);
    }
};
#ifndef EPI_MINST
#define EPI_MINST 16
#endif
struct EpiIn {
    static constexpr bool PERM = true, AFTER_DRAIN = false; static constexpr int MIN_STORES = EPI_MINST;
    bf16 *Q, *K, *V, *ZA, *XL, *ZL, *GA, *GL; GAS float* out; int l;
    __device__ __forceinline__ void operator()(const pg8::f32x4 (&acc)[2][2][4][2], const pg8::Unit& u, int wr, int wc, int fr, int fq) const {
#ifdef PROBE_FIXPN
        int upm = u.pm, upn = u.pn;
        const int fix = this->l >> 8, l = this->l & 255;
        if (fix) { const int bx = blockIdx.x, v = (bx % 8) * 32 + bx / 8; upm = (v >> 2) & 31; upn = PROBE_FIXPN + (v >> 7); }
        const int row0 = upm * 256 + wr * 64 + fr, ct = upn * 256, cl = wc * 32 + 8 * fq;
#else
        const int row0 = u.pm * 256 + wr * 64 + fr, ct = u.pn * 256, cl = wc * 32 + 8 * fq;
#endif
        GAS float* out = this->out; asm volatile("" : "+s"(out));
        int mode, ld, cc; bf16* base;
        if (ct < C_K) { mode = 0; base = Q; ld = QKVW; cc = ct; }
        else if (ct < C_V) { mode = 1; base = K; ld = QKVW; cc = ct - C_K; }
        else if (ct < C_ZA) { mode = 2; base = V; ld = QKVW; cc = ct - C_V; }
        else if (ct < C_XL) { mode = 6; base = ZA; ld = ATTW; cc = ct - C_ZA; }
        else if (ct < C_ZL) { mode = 4; base = XL; ld = DM; cc = ct - C_XL; }
        else if (ct < C_GA) { mode = 3; base = ZL; ld = DM; cc = ct - C_ZL; }
        else if (ct < C_GL) { mode = 5; base = GA; ld = DM; cc = ct - C_GA; }
        else { mode = 5; base = GL; ld = DM; cc = ct - C_GL; }
        const int gi = cc >> 10;
        const int Wg = gi == 0 ? 128 : (gi == 1 ? 512 : 2048);
        GAS float* kvp = out + (gi == 0 ? O_KVP0 : (gi == 1 ? O_KVP1 : O_KVP2));
        GAS float* kvs = out + (gi == 0 ? O_KVS0 : (gi == 1 ? O_KVS1 : O_KVS2));
#pragma unroll
        for (int ai = 0; ai < 2; ++ai)
#pragma unroll
            for (int m = 0; m < 4; ++m) {
                const int r = row0 + ai * 128 + m * 16;
                bf16* rowp = base + (size_t)r * ld + cc + cl;
                GAS float* f32dst = nullptr;
                if (mode == 1 || mode == 2) {
                    if (r < MP) { const int b = r >> 11, t = r & 2047; if (t >= TT - Wg) f32dst = kvp + (((size_t)(l * NB_P + b) * Wg + (t - (TT - Wg))) * 2 + (mode - 1)) * 1024 + (cc & 1023); }
                    else if (r < MR) { const int bs = (r - MP) >> 2, s = (r - MP) & 3; f32dst = kvs + (((size_t)(l * NB_S + bs) * Wg + (Wg - 4 + s)) * 2 + (mode - 1)) * 1024 + (cc & 1023); }
                } else if (mode == 4) {
                    if (r < MP) { const int b = r >> 11, t = r & 2047; if (t >= TT - 3) f32dst = out + O_CVP + ((size_t)(l * NB_P + b) * 3 + (t - (TT - 3))) * DM + cc; }
                    else if (r < MR) { const int bs = (r - MP) >> 2, s = (r - MP) & 3; if (s >= 1) f32dst = out + O_CVS + ((size_t)(l * NB_S + bs) * 3 + (s - 1)) * DM + cc; }
                }
#pragma unroll
                for (int bj = 0; bj < 2; ++bj) {
                    pg8::f32x4 v0 = acc[ai][bj][m][0], v1 = acc[ai][bj][m][1];
                    if (f32dst) { __builtin_nontemporal_store(v0, (GAS pg8::f32x4*)(f32dst + cl + bj * 128)); __builtin_nontemporal_store(v1, (GAS pg8::f32x4*)(f32dst + cl + bj * 128 + 4)); }
                    if (mode == 0) { v0 = v0 * QSCALE; v1 = v1 * QSCALE; }
                    else if (mode == 3) {
#pragma unroll
                        for (int j = 0; j < 4; ++j) { v0[j] = v0[j] * sigm(v0[j]); v1[j] = v1[j] * sigm(v1[j]); }
                    } else if (mode == 5) {
#pragma unroll
                        for (int j = 0; j < 4; ++j) { v0[j] = sigm(v0[j]); v1[j] = sigm(v1[j]); }
                    }
                    u32x4 w; w.x = pk2(v0[0], v0[1]); w.y = pk2(v0[2], v0[3]); w.z = pk2(v1[0], v1[1]); w.w = pk2(v1[2], v1[3]);
#ifdef EPI_NT_BF16
                    __builtin_nontemporal_store(w, (u32x4*)(rowp + bj * 128));
#else
                    *(u32x4*)(rowp + bj * 128) = w;
#endif
                }
            }
    }
};
struct EpiPA {
    static constexpr bool PERM = true, AFTER_DRAIN = false; static constexpr int MIN_STORES = 0;
    const bf16* GA; bf16* TMP;
    __device__ __forceinline__ void operator()(const pg8::f32x4 (&acc)[2][2][4][2], const pg8::Unit& u, int wr, int wc, int fr, int fq) const {
        const int row0 = u.pm * 256 + wr * 64 + fr, col0 = u.pn * 256 + wc * 32 + 8 * fq;
#pragma unroll
        for (int ai = 0; ai < 2; ++ai)
#pragma unroll
            for (int m = 0; m < 4; ++m) {
                const size_t ro = (size_t)(row0 + ai * 128 + m * 16) * DM + col0;
#pragma unroll
                for (int bj = 0; bj < 2; ++bj) {
                    const u32x4 g = *(const u32x4*)(GA + ro + bj * 128);
                    pg8::f32x4 v0 = acc[ai][bj][m][0], v1 = acc[ai][bj][m][1];
                    v0[0] *= bflo(g.x); v0[1] *= bfhi(g.x); v0[2] *= bflo(g.y); v0[3] *= bfhi(g.y);
                    v1[0] *= bflo(g.z); v1[1] *= bfhi(g.z); v1[2] *= bflo(g.w); v1[3] *= bfhi(g.w);
                    u32x4 w; w.x = pk2(v0[0], v0[1]); w.y = pk2(v0[2], v0[3]); w.z = pk2(v1[0], v1[1]); w.w = pk2(v1[2], v1[3]);
                    *(u32x4*)(TMP + ro + bj * 128) = w;
                }
                asm volatile("" ::: "memory");
            }
    }
};
struct EpiPB {
    static constexpr bool PERM = true, AFTER_DRAIN = false; static constexpr int MIN_STORES = 0;
    const bf16* GL; const bf16* TMP; bf16* MG;
    __device__ __forceinline__ void operator()(const pg8::f32x4 (&acc)[2][2][4][2], const pg8::Unit& u, int wr, int wc, int fr, int fq) const {
        const int row0 = u.pm * 256 + wr * 64 + fr, col0 = u.pn * 256 + wc * 32 + 8 * fq;
#pragma unroll
        for (int ai = 0; ai < 2; ++ai)
#pragma unroll
            for (int m = 0; m < 4; ++m) {
                const size_t ro = (size_t)(row0 + ai * 128 + m * 16) * DM + col0;
#pragma unroll
                for (int bj = 0; bj < 2; ++bj) {
                    const u32x4 g = *(const u32x4*)(GL + ro + bj * 128);
                    const u32x4 tw = *(const u32x4*)(TMP + ro + bj * 128);
                    const pg8::f32x4 t0 = (pg8::f32x4){bflo(tw.x), bfhi(tw.x), bflo(tw.y), bfhi(tw.y)}, t1 = (pg8::f32x4){bflo(tw.z), bfhi(tw.z), bflo(tw.w), bfhi(tw.w)};
                    pg8::f32x4 v0 = acc[ai][bj][m][0], v1 = acc[ai][bj][m][1];
                    v0[0] = t0[0] + v0[0] * bflo(g.x); v0[1] = t0[1] + v0[1] * bfhi(g.x); v0[2] = t0[2] + v0[2] * bflo(g.y); v0[3] = t0[3] + v0[3] * bfhi(g.y);
                    v1[0] = t1[0] + v1[0] * bflo(g.z); v1[1] = t1[1] + v1[1] * bfhi(g.z); v1[2] = t1[2] + v1[2] * bflo(g.w); v1[3] = t1[3] + v1[3] * bfhi(g.w);
                    u32x4 w; w.x = pk2(v0[0], v0[1]); w.y = pk2(v0[2], v0[3]); w.z = pk2(v1[0], v1[1]); w.w = pk2(v1[2], v1[3]);
                    *(u32x4*)(MG + ro + bj * 128) = w;
                }
                asm volatile("" ::: "memory");
            }
    }
};
struct EpiMerge {
    static constexpr bool PERM = true, AFTER_DRAIN = false; static constexpr int MIN_STORES = 0;
    const bf16* GA; const bf16* GL; bf16* MG;
    static __device__ __forceinline__ float clampg(float g) { return fmaxf(g, 8.673617379884035e-19f); }
    __device__ __forceinline__ void mid(pg8::f32x4 (&acc)[2][2][4][2], const pg8::Unit& u, int wr, int wc, int fr, int fq) const {
        const GAS bf16* GA = (const GAS bf16*)this->GA; const GAS bf16* GL = (const GAS bf16*)this->GL; asm volatile("" : "+s"(GA), "+s"(GL), "+v"(fr), "+v"(fq));
        const int row0 = u.pm * 256 + wr * 64 + fr, col0 = u.pn * 256 + wc * 32 + 8 * fq;
#pragma unroll
        for (int ai = 0; ai < 2; ++ai)
#pragma unroll
            for (int mp = 0; mp < 4; mp += 2) {
                u32x4 a[2][2], g[2][2];
#pragma unroll
                for (int mm = 0; mm < 2; ++mm)
#pragma unroll
                    for (int bj = 0; bj < 2; ++bj) { const size_t ro = (size_t)(row0 + ai * 128 + (mp + mm) * 16) * DM + col0 + bj * 128; a[mm][bj] = *(const GAS u32x4*)(GA + ro); g[mm][bj] = *(const GAS u32x4*)(GL + ro); }
#pragma unroll
                for (int mm = 0; mm < 2; ++mm) {
#pragma unroll
                    for (int bj = 0; bj < 2; ++bj)
#pragma unroll
                        for (int e = 0; e < 4; ++e) {
                            acc[ai][bj][mp + mm][e >> 1][2 * (e & 1)] *= bflo(a[mm][bj][e]) * __builtin_amdgcn_rcpf(clampg(bflo(g[mm][bj][e])));
                            acc[ai][bj][mp + mm][e >> 1][2 * (e & 1) + 1] *= bfhi(a[mm][bj][e]) * __builtin_amdgcn_rcpf(clampg(bfhi(g[mm][bj][e])));
                        }
                    asm volatile("" : "+v"(acc[ai][0][mp + mm][0]), "+v"(acc[ai][0][mp + mm][1]), "+v"(acc[ai][1][mp + mm][0]), "+v"(acc[ai][1][mp + mm][1]) :: "memory");
                }
            }
    }
    __device__ __forceinline__ void operator()(const pg8::f32x4 (&acc)[2][2][4][2], const pg8::Unit& u, int wr, int wc, int fr, int fq) const {
        const GAS bf16* GL = (const GAS bf16*)this->GL; GAS bf16* MG = (GAS bf16*)this->MG; asm volatile("" : "+s"(GL), "+s"(MG), "+v"(fr), "+v"(fq));
        const int row0 = u.pm * 256 + wr * 64 + fr, col0 = u.pn * 256 + wc * 32 + 8 * fq;
#pragma unroll
        for (int ai = 0; ai < 2; ++ai)
#pragma unroll
            for (int mp = 0; mp < 4; mp += 2) {
                u32x4 g[2][2];
#pragma unroll
                for (int mm = 0; mm < 2; ++mm)
#pragma unroll
                    for (int bj = 0; bj < 2; ++bj) g[mm][bj] = *(const GAS u32x4*)(GL + (size_t)(row0 + ai * 128 + (mp + mm) * 16) * DM + col0 + bj * 128);
#pragma unroll
                for (int mm = 0; mm < 2; ++mm)
#pragma unroll
                    for (int bj = 0; bj < 2; ++bj) {
                        u32x4 w;
#pragma unroll
                        for (int e = 0; e < 4; ++e) w[e] = pk2(acc[ai][bj][mp + mm][e >> 1][2 * (e & 1)] * clampg(bflo(g[mm][bj][e])), acc[ai][bj][mp + mm][e >> 1][2 * (e & 1) + 1] * clampg(bfhi(g[mm][bj][e])));
                        *(GAS u32x4*)(MG + (size_t)(row0 + ai * 128 + (mp + mm) * 16) * DM + col0 + bj * 128) = w;
                    }
                asm volatile("" ::: "memory");
            }
    }
};
struct EpiOut {
    static constexpr bool PERM = false, AFTER_DRAIN = false; static constexpr int MIN_STORES = 0;
    const float* xp; const float* xs; float* X; const float* mod; int l;
    __device__ __forceinline__ void operator()(const pg8::f32x4 (&acc)[2][2][4][2], const pg8::Unit& u, int wr, int wc, int fr, int fq) const {
        const GAS float* xo = (const GAS float*)(l == 0 ? xp : X); GAS float* Xn = (GAS float*)X; const GAS float* gp = (const GAS float*)mod + ((size_t)(l * NMODB + (u.pm >> 3))) * 6144 + 4096;
        asm volatile("" : "+s"(xo), "+s"(Xn), "+s"(gp), "+v"(fr), "+v"(fq));
        const int row0 = u.pm * 256 + wr * 64 + fr, col0 = u.pn * 256 + wc * 32 + 4 * fq;
        pg8::f32x4 g4[2][2];
#pragma unroll
        for (int bj = 0; bj < 2; ++bj)
#pragma unroll
            for (int n = 0; n < 2; ++n) g4[bj][n] = *(const GAS pg8::f32x4*)(gp + col0 + bj * 128 + n * 16);
#pragma unroll
        for (int ai = 0; ai < 2; ++ai)
#pragma unroll
            for (int mp = 0; mp < 4; mp += 2) {
                pg8::f32x4 x4[2][2][2];
#pragma unroll
                for (int mm = 0; mm < 2; ++mm)
#pragma unroll
                    for (int bj = 0; bj < 2; ++bj)
#pragma unroll
                        for (int n = 0; n < 2; ++n) x4[mm][bj][n] = *(const GAS pg8::f32x4*)(xo + (size_t)(row0 + ai * 128 + (mp + mm) * 16) * DM + col0 + bj * 128 + n * 16);
#pragma unroll
                for (int mm = 0; mm < 2; ++mm)
#pragma unroll
                    for (int bj = 0; bj < 2; ++bj)
#pragma unroll
                        for (int n = 0; n < 2; ++n) *(GAS pg8::f32x4*)(Xn + (size_t)(row0 + ai * 128 + (mp + mm) * 16) * DM + col0 + bj * 128 + n * 16) = x4[mm][bj][n] + g4[bj][n] * acc[ai][bj][mp + mm][n];
                asm volatile("" ::: "memory");
            }
    }
};
template <bool P> struct EpiNull {
    static constexpr bool PERM = P, AFTER_DRAIN = false; static constexpr int MIN_STORES = 0;
    __device__ __forceinline__ void mid(pg8::f32x4 (&acc)[2][2][4][2], const pg8::Unit&, int, int, int, int) const {}
    __device__ __forceinline__ void operator()(const pg8::f32x4 (&acc)[2][2][4][2], const pg8::Unit&, int, int, int, int) const {
#pragma unroll
        for (int a = 0; a < 2; ++a)
#pragma unroll
            for (int b = 0; b < 2; ++b)
#pragma unroll
                for (int m = 0; m < 4; ++m)
#pragma unroll
                    for (int n = 0; n < 2; ++n) asm volatile("" :: "v"(acc[a][b][m][n]));
    }
};
#define XB_TMO      128
#define XB_XCNT(j)  (256  + 64 * (j))
#define XB_XSUB(j)  (1280 + 64 * (j))
#define XB_XGEN(j)  (2304 + 64 * (j))
#define XB_TOP      3328
#define XB_TOPGEN   3392
#define XCD_BAR_WORDS 3456
#define XB_SPIN_CAP (1u << 18)

__device__ __forceinline__ unsigned xb_ld(unsigned* p)              { return __hip_atomic_load(p, __ATOMIC_RELAXED, __HIP_MEMORY_SCOPE_AGENT); }
__device__ __forceinline__ unsigned xb_add(unsigned* p, unsigned v) { return __hip_atomic_fetch_add(p, v, __ATOMIC_RELAXED, __HIP_MEMORY_SCOPE_AGENT); }
__device__ __forceinline__ unsigned xb_xcc_id() { return (unsigned)__builtin_amdgcn_s_getreg((3 << 11) | 20) & 0xFu; }
#define XB_SPIN(cond, bar) do { unsigned _sp = 0; while (cond) { __builtin_amdgcn_s_sleep(1); \
    if ((++_sp & 255u) == 0u) { if (xb_ld(&(bar)[XB_TMO])) break; if (_sp > XB_SPIN_CAP) { atomicAdd(&(bar)[XB_TMO], 1u); break; } } } } while (0)

struct XcdBarrier {
    unsigned* bar; unsigned x;
    volatile LAS unsigned* st;
};

__device__ __forceinline__ XcdBarrier xcd_barrier_post(unsigned* bar, volatile LAS unsigned* st) {
    XcdBarrier b; b.bar = bar; b.x = xb_xcc_id(); b.st = st;
    if (threadIdx.x == 0) (void)xb_add(&bar[XB_XCNT(b.x)], 1u);
    return b;
}
__device__ __forceinline__ void xcd_barrier_complete(unsigned* bar, unsigned x, unsigned& nloc, unsigned& nx) {
    const unsigned G = gridDim.x * gridDim.y * gridDim.z;
    unsigned sum, cnt, mine, sp = 0u;
    for (;;) {
        sum = 0u; cnt = 0u; mine = 0u;
#pragma unroll
        for (unsigned j = 0; j < 16; ++j) { const unsigned c = xb_ld(&bar[XB_XCNT(j)]); sum += c; cnt += (c > 0u) ? 1u : 0u; mine = (j == x) ? c : mine; }
        if (sum == G) break;
        __builtin_amdgcn_s_sleep(1);
        if ((++sp & 255u) == 0u) { if (xb_ld(&bar[XB_TMO])) break; if (sp > XB_SPIN_CAP) { atomicAdd(&bar[XB_TMO], 1u); break; } }
    }
    nloc = mine > 0u ? mine : 1u; nx = cnt > 0u ? cnt : 1u;
}

__device__ __forceinline__ void xcd_barrier(const XcdBarrier& b, bool is_t0  ) {
    asm volatile("s_waitcnt vmcnt(0)" ::: "memory");
    __syncthreads();
    if (is_t0) {
        unsigned* bar = b.bar;
        __builtin_amdgcn_s_waitcnt(0);
        unsigned nloc = b.st[0], nx = b.st[1];
        if (nloc == 0u) { xcd_barrier_complete(bar, b.x, nloc, nx); b.st[0] = nloc; b.st[1] = nx; }
        const unsigned old = xb_add(&bar[XB_XSUB(b.x)], 1u);
        const unsigned gen = old / nloc;
        if (old + 1u == (gen + 1u) * nloc) {
            __builtin_amdgcn_fence(__ATOMIC_RELEASE, "agent");
            asm volatile("s_waitcnt vmcnt(0)" ::: "memory");
            const unsigned og = xb_add(&bar[XB_TOP], 1u);
            const unsigned tg = og / nx;
            if (og + 1u == (tg + 1u) * nx) xb_add(&bar[XB_TOPGEN], 1u);
            else XB_SPIN(xb_ld(&bar[XB_TOPGEN]) == tg, bar);
            __builtin_amdgcn_fence(__ATOMIC_ACQUIRE, "agent");
            xb_add(&bar[XB_XGEN(b.x)], 1u);
            asm volatile("s_waitcnt vmcnt(0)" ::: "memory");
        } else {
            XB_SPIN(xb_ld(&bar[XB_XGEN(b.x)]) == gen, bar);
            __builtin_amdgcn_fence(__ATOMIC_ACQUIRE, "agent");
            asm volatile("s_waitcnt vmcnt(0)" ::: "memory");
        }
    }
    __syncthreads();
}

struct TrDesc { const float* W; bf16* WT; int K, N, item, ldt; };
__device__ __forceinline__ void tr_load(const TrDesc& d, int lane, f32x4 (&v)[16]) {
    const int nblk = d.N >> 6, kb = d.item / nblk, nb = d.item - kb * nblk, k0 = kb * 64, n0 = nb * 64, lr = lane >> 4, lc = lane & 15;
#pragma unroll
    for (int i = 0; i < 16; ++i) v[i] = __builtin_nontemporal_load((const f32x4*)(d.W + (size_t)(k0 + 4 * i + lr) * d.N + n0 + 4 * lc));
}
__device__ __forceinline__ void tr_to_lds(LAS float* scr, int lane, const f32x4 (&v)[16]) {
    const int lr = lane >> 4, lc = lane & 15;
#pragma unroll
    for (int i = 0; i < 16; ++i) { const int k = 4 * i + lr; *(LAS f32x4*)(scr + k * 64 + ((lc ^ ((k >> 3) & 7)) << 2)) = v[i]; }
}
__device__ __forceinline__ void tr_store(const TrDesc& d, LAS float* scr, int lane) {
    const int nblk = d.N >> 6, kb = d.item / nblk, nb = d.item - kb * nblk, k0 = kb * 64, n0 = nb * 64;
    const int c = lane & 7;
#pragma unroll
    for (int j = 0; j < 8; ++j) {
        const int n = (lane >> 3) + 8 * j;
        const LAS float* s = scr + (8 * c) * 64 + (((n >> 2) ^ c) << 2) + (n & 3);
        u32x4 o; o.x = pk2(s[0 * 64], s[1 * 64]); o.y = pk2(s[2 * 64], s[3 * 64]); o.z = pk2(s[4 * 64], s[5 * 64]); o.w = pk2(s[6 * 64], s[7 * 64]);
        *(u32x4*)(d.WT + (size_t)(n0 + n) * d.ldt + k0 + 8 * c) = o;
    }
}
__device__ __forceinline__ void mod_item(const Frame& F, LAS float* scr, int item) {
    const KArgs A = kargs();
    int lane = F.lane; asm volatile("" : "+v"(lane));
    const int l = item / 384, r = item - l * 384, cg = r >> 4, kc = r & 15;
    const float* cp = KIN(A, CP); const float* cs = KIN(A, CS);
    for (int idx = lane; idx < NMODB * 128; idx += 64) {
        const int b = idx >> 7, k = idx & 127;
        const float cv = b < NB_P ? cp[b * DM + kc * 128 + k] : cs[(b - NB_P) * DM + kc * 128 + k];
        scr[k * 16 + b] = cv * sigm(cv);
    }
    LDS_WAIT();
    f32x4 acc[NMODB];
#pragma unroll
    for (int b = 0; b < NMODB; ++b) acc[b] = (f32x4){0.f, 0.f, 0.f, 0.f};
    const float* wp = KIN(A, WADA) + (size_t)l * DM * 6144 + (size_t)(kc * 128) * 6144 + cg * 256 + lane * 4;
#pragma unroll 16
    for (int k = 0; k < 128; ++k) {
        const f32x4 w = __builtin_nontemporal_load((const f32x4*)(wp + (size_t)k * 6144));
        const f32x4 s0 = *(const LAS f32x4*)(scr + k * 16), s1 = *(const LAS f32x4*)(scr + k * 16 + 4), s2 = *(const LAS f32x4*)(scr + k * 16 + 8);
        acc[0] += s0[0] * w; acc[1] += s0[1] * w; acc[2] += s0[2] * w; acc[3] += s0[3] * w;
        acc[4] += s1[0] * w; acc[5] += s1[1] * w; acc[6] += s1[2] * w; acc[7] += s1[3] * w;
        acc[8] += s2[0] * w; acc[9] += s2[1] * w; acc[10] += s2[2] * w; acc[11] += s2[3] * w;
    }
    float* mp = (float*)(F.ws + WS_MODP) + ((size_t)(l * 16 + kc) * NMODB) * 6144 + cg * 256 + lane * 4;
#pragma unroll
    for (int b = 0; b < NMODB; ++b) *(f32x4*)(mp + (size_t)b * 6144) = acc[b];
    LDS_WAIT();
}
__device__ __forceinline__ void p0_prologue(const Frame& F) {
    const KArgs A = kargs();
    LAS float* scr = (LAS float*)(F.lds + F.wave * 16384);
    const int gw = F.vcu * 8 + F.wave, NGW = F.G * 8;
    constexpr int I_IN = 32 * 288, I_PA = 16 * 32, I_PB = 32 * 32, I_OUT = 32 * 32, I_RI = 16 * 4;
    constexpr int PER_L = I_IN + I_PA + I_PB + I_OUT + 2 * I_RI, NTR = DEPTH * PER_L, NMOD = DEPTH * 24 * 16;
    auto decode = [&](int it) -> TrDesc {
        TrDesc d; const int l = it / PER_L; int r = it - l * PER_L;
        if (r < I_IN) { d.W = KIN(A, WIN) + (size_t)l * DM * INC; d.K = DM; d.N = INC; d.ldt = DM; d.WT = (bf16*)(F.ws + WS_WIN) + (size_t)l * INC * DM; d.item = r; return d; } r -= I_IN;
        if (r < I_PA) { d.W = KIN(A, WPA) + (size_t)l * ATTW * DM; d.K = ATTW; d.N = DM; d.ldt = DM; d.WT = (bf16*)(F.ws + WS_WPA) + (size_t)l * DM * DM; d.item = r; return d; } r -= I_PA;
        if (r < I_PB) { d.W = KIN(A, WPB) + (size_t)l * DM * DM; d.K = DM; d.N = DM; d.ldt = DM; d.WT = (bf16*)(F.ws + WS_WPB) + (size_t)l * DM * DM; d.item = r; return d; } r -= I_PB;
        if (r < I_OUT) { d.W = KIN(A, WOUT) + (size_t)l * DM * DM; d.K = DM; d.N = DM; d.ldt = DM; d.WT = (bf16*)(F.ws + WS_WOUT) + (size_t)l * DM * DM; d.item = r; return d; } r -= I_OUT;
        if (r < I_RI) { const int nb = r >> 2; d.W = KIN(A, WR) + (size_t)(l * 16 + nb) * 16384; d.K = 128; d.N = 128; d.ldt = 128; d.WT = (bf16*)(F.ws + WS_WR) + (size_t)(l * 16 + nb) * 16384; d.item = r & 3; return d; } r -= I_RI;
        { const int nb = r >> 2; d.W = KIN(A, WI) + (size_t)(l * 16 + nb) * 16384; d.K = 128; d.N = 128; d.ldt = 128; d.WT = (bf16*)(F.ws + WS_WI) + (size_t)(l * 16 + nb) * 16384; d.item = r & 3; return d; }
    };
    {
        f32x4 va[16], vb[16]; int it = gw; TrDesc d0{}, d1{};
        if (it < NTR) { d0 = decode(it); tr_load(d0, F.lane, va); }
        if (it + NGW < NTR) { d1 = decode(it + NGW); tr_load(d1, F.lane, vb); }
#pragma unroll 1
        while (it < NTR) {
            int lane = F.lane; asm volatile("" : "+v"(lane));
            {
                tr_to_lds(scr, lane, va); LDS_WAIT();
                const int nx = it + 2 * NGW; TrDesc dn{};
                if (nx < NTR) { dn = decode(nx); tr_load(dn, lane, va); }
                tr_store(d0, scr, lane); LDS_WAIT();
                d0 = dn;
            }
            if (it + NGW < NTR) {
                tr_to_lds(scr, lane, vb); LDS_WAIT();
                const int nx = it + 3 * NGW; TrDesc dn{};
                if (nx < NTR) { dn = decode(nx); tr_load(dn, lane, vb); }
                tr_store(d1, scr, lane); LDS_WAIT();
                d1 = dn;
            }
            it += 2 * NGW;
        }
    }
#pragma unroll 1
    for (int it = gw; it < NMOD; it += NGW) mod_item(F, scr, it);
    {
        unsigned* q = (unsigned*)(F.ws + WS_CTL) + CW_P0Q;
        constexpr int CPR = KVC_REM / 512, NCLAIM = 4 * CPR / 4;
        static_assert(KVC_REM % 512 == 0, "copy chunks");
        int lane0 = F.lane; asm volatile("" : "+v"(lane0));
        unsigned gv = 0u; if (lane0 == 0) gv = __hip_atomic_fetch_add(q, 1u, __ATOMIC_RELAXED, __HIP_MEMORY_SCOPE_AGENT);
#pragma unroll 1
        for (;;) {
            const int cl = (int)__builtin_amdgcn_readfirstlane(gv);
            if (cl >= NCLAIM) break;
            gv = 0u; if (lane0 == 0) gv = __hip_atomic_fetch_add(q, 1u, __ATOMIC_RELAXED, __HIP_MEMORY_SCOPE_AGENT);
#pragma unroll 1
            for (int h = 0; h < 2; ++h) {
                f32x4 v[16]; f32x4* dp[16];
#pragma unroll
                for (int j = 0; j < 16; ++j) {
                    const int c = 4 * cl + 2 * h + (j >> 3), qq = c / CPR; const f32x4* sp;
                    kvc_map(A, F.out, (qq + 1) * KVC_LQ - KVC_REM + (c - qq * CPR) * 512 + (j & 7) * 64 + lane0, sp, dp[j]); v[j] = __builtin_nontemporal_load(sp); }
#pragma unroll
                for (int j = 0; j < 16; ++j) __builtin_nontemporal_store(v[j], dp[j]);
            }
        }
    }
}
__device__ __forceinline__ void p1_modreduce(const Frame& F) {
    const KArgs A = kargs();
    const int gt = (F.vcu * 8 + F.wave) * 64 + F.lane, NT = F.G * 512;
    const float* modp = (const float*)(F.ws + WS_MODP); float* mod = (float*)(F.ws + WS_MOD);
    for (int i = gt; i < DEPTH * NMODB * 6144; i += NT) {
        const int l = i / (NMODB * 6144), r = i - l * (NMODB * 6144), b = r / 6144, n = r - b * 6144;
        float s = KIN(A, BADA)[l * 6144 + n];
#pragma unroll
        for (int kc = 0; kc < 16; ++kc) s += modp[((size_t)(l * 16 + kc) * NMODB + b) * 6144 + n];
        mod[i] = s;
    }
}
__device__ __forceinline__ float sumsq8(const f32x4 (&v)[8]) {
    float ss = 0.f;
#pragma unroll
    for (int j = 0; j < 8; ++j) ss += (v[j][0] * v[j][0] + v[j][1] * v[j][1]) + (v[j][2] * v[j][2] + v[j][3] * v[j][3]);
    return ss;
}
__device__ __forceinline__ void phase_norm(const Frame& F, int l) {
    const KArgs A = kargs();
    const int gw = F.vcu * 8 + F.wave, NGW = F.G * 8, lane = F.lane;
    bf16* H = (bf16*)(F.ws + WS_H); const float* X = (const float*)(F.ws + WS_X); const float* mod = (const float*)(F.ws + WS_MOD);
    const f32x4* g4 = (const f32x4*)(KIN(A, NORMG) + l * DM);
#pragma unroll 1
    for (int r0 = 4 * gw; r0 < MP + 4 * MS; r0 += 4 * NGW) {
        const bool prompt = r0 < MP; const int rbase = prompt ? r0 : MP + ((r0 - MP) >> 2), nrow = prompt ? 4 : 1;
        const int b = prompt ? (rbase >> 11) : NB_P + ((rbase - MP) >> 2);
        const float* xbase = (l == 0) ? (prompt ? KIN(A, XP) + (size_t)rbase * DM : KIN(A, XS) + (size_t)(rbase - MP) * DM) : X + (size_t)rbase * DM;
        const f32x4* sh4 = (const f32x4*)(mod + (size_t)(l * NMODB + b) * 6144); const f32x4* sc4 = sh4 + 512;
        f32x4 v[8], vn[8], G[8], S[8];
#pragma unroll
        for (int j = 0; j < 8; ++j) v[j] = ((const f32x4*)xbase)[lane + 64 * j];
#pragma unroll
        for (int j = 0; j < 8; ++j) { G[j] = g4[lane + 64 * j] * (sc4[lane + 64 * j] + 1.0f); S[j] = sh4[lane + 64 * j]; }
#pragma unroll
        for (int k = 0; k < 4; ++k) if (k < nrow) {
            if (k + 1 < nrow) {
#pragma unroll
                for (int j = 0; j < 8; ++j) vn[j] = ((const f32x4*)(xbase + (size_t)(k + 1) * DM))[lane + 64 * j];
            }
            const float rstd = 1.0f / sqrtf(wave_sum(sumsq8(v), lane) * (1.0f / DM) + RMS_EPS);
            u32x2* ho = (u32x2*)(H + (size_t)(rbase + k) * DM) + lane;
#pragma unroll
            for (int j = 0; j < 8; ++j) { const f32x4 o = (v[j] * rstd) * G[j] + S[j]; ho[64 * j] = (u32x2){pk2(o[0], o[1]), pk2(o[2], o[3])}; }
#pragma unroll
            for (int j = 0; j < 8; ++j) v[j] = vn[j];
        }
    }
}
__device__ __forceinline__ void phase_final(const Frame& F) {
    const KArgs A = kargs();
    const int gw = F.vcu * 8 + F.wave, NGW = F.G * 8, lane = F.lane;
    const float* X = (const float*)(F.ws + WS_X); const f32x4* g4 = (const f32x4*)KIN(A, FING);
    f32x4 G[8];
#pragma unroll
    for (int j = 0; j < 8; ++j) G[j] = g4[lane + 64 * j];
#pragma unroll 1
    for (int r0 = 4 * gw; r0 < MP + 4 * MS; r0 += 4 * NGW) {
        const bool prompt = r0 < MP; const int rbase = prompt ? r0 : MP + ((r0 - MP) >> 2), nrow = prompt ? 4 : 1;
        const float* xbase = X + (size_t)rbase * DM;
        float* ybase = (float*)F.out + (prompt ? O_YP + (size_t)rbase * DM : O_YS + (size_t)(rbase - MP) * DM);
        f32x4 v[8], vn[8];
#pragma unroll
        for (int j = 0; j < 8; ++j) v[j] = ((const f32x4*)xbase)[lane + 64 * j];
#pragma unroll
        for (int k = 0; k < 4; ++k) if (k < nrow) {
            if (k + 1 < nrow) {
#pragma unroll
                for (int j = 0; j < 8; ++j) vn[j] = ((const f32x4*)(xbase + (size_t)(k + 1) * DM))[lane + 64 * j];
            }
            const float rstd = 1.0f / sqrtf(wave_sum(sumsq8(v), lane) * (1.0f / DM) + RMS_EPS);
            f32x4* yo = (f32x4*)(ybase + (size_t)k * DM) + lane;
#pragma unroll
            for (int j = 0; j < 8; ++j) yo[64 * j] = (v[j] * rstd) * G[j];
#pragma unroll
            for (int j = 0; j < 8; ++j) v[j] = vn[j];
        }
    }
}

__device__ __forceinline__ pg8::f32x4 mfma16(bf16x8 a, bf16x8 b, pg8::f32x4 c) { return __builtin_amdgcn_mfma_f32_16x16x32_bf16(a, b, c, 0, 0, 0); }
__device__ __forceinline__ s16x4 tr16(const LAS unsigned char* p) { return __builtin_bit_cast(s16x4, __builtin_amdgcn_ds_read_tr16_b64_v4i16((LAS s16x4*)p)); }

struct AttnU { int b, g, h, cls, n; };
__device__ __forceinline__ AttnU attn_decode(int id) {
    AttnU u; const int bh = id & 31, x = id >> 5, blk = x & 15; u.g = x >> 4; u.b = bh >> 3; u.h = bh & 7;
    u.cls = u.g == 0 ? 0 : (u.g == 1 ? (blk & 3) : blk); u.n = u.g == 0 ? blk : (u.g == 1 ? (blk >> 2) : 0); return u;
}
__device__ __forceinline__ void attn_request(const Frame& F, const AttnU& u, int tid, int wave, u32x4 (&kreg)[8], bf16x8 (&qf)[4]) {
    const bf16* Q = (const bf16*)(F.ws + WS_Q); const bf16* K = (const bf16*)(F.ws + WS_K);
    const int dil = u.g == 0 ? 1 : (u.g == 1 ? 4 : 16), gh = u.g * 8 + u.h, kk_lo = (u.n == 0) ? 128 : 0, npass = (256 - kk_lo) >> 5;
    const int c16 = tid & 15, rr = tid >> 4, lane = tid & 63;
#pragma unroll
    for (int p = 0; p < 8; ++p) if (p < npass) {
        const int kk = kk_lo + 32 * p + rr, uk = 128 * (u.n - 1) + kk;
        const size_t off = ((size_t)(u.b * TT + uk * dil + u.cls)) * QKVW + gh * 128 + c16 * 8;
        kreg[p] = *(const u32x4*)(K + off);
    }
    const size_t qrow = (size_t)(u.b * TT + (128 * u.n + 16 * wave + (lane & 15)) * dil + u.cls);
#pragma unroll
    for (int ks = 0; ks < 4; ++ks) qf[ks] = *(const bf16x8*)(Q + qrow * QKVW + gh * 128 + 32 * ks + 8 * (lane >> 4));
}
template <int NT>
__device__ __forceinline__ void attn_compute(const LAS unsigned char* Kl, const LAS unsigned char* Vl, const LAS float* biasP, const bf16x8 (&qf)[4], int kkb, int iq, int lane,
                                             bf16* orow, float* lsep, const f32x4 (&cv)[KVC_RIDE > 0 ? KVC_RIDE : 1], KArgs A, GAS float* outp, int cbase, int cgrp) {
    const int q = lane & 15, gq = lane >> 4;
    pg8::f32x4 st[NT];
    {
        bf16x8 kf[2][4];
#define ATT_LDK(buf, t_) do { const int kk_ = kkb + 16 * (t_) + q; \
            _Pragma("unroll") for (int ks_ = 0; ks_ < 4; ++ks_) kf[buf][ks_] = *(const LAS bf16x8*)(Kl + kk_ * 256 + (((4 * ks_ + gq) ^ (kk_ & 15)) << 4)); } while (0)
        ATT_LDK(0, 0);
#pragma unroll
        for (int t = 0; t < NT; ++t) {
            if (t + 1 < NT) ATT_LDK((t + 1) & 1, t + 1);
            __builtin_amdgcn_sched_barrier(0);
            st[t] = (pg8::f32x4){0.f, 0.f, 0.f, 0.f};
#pragma unroll
            for (int ks = 0; ks < 4; ++ks) st[t] = mfma16(kf[t & 1][ks], qf[ks], st[t]);
            __builtin_amdgcn_sched_barrier(0);
        }
#undef ATT_LDK
    }
    const LAS float* bp = biasP + (iq + 128 - kkb - 4 * gq + 160);
    float mx = -1e30f;
#pragma unroll
    for (int t = 0; t < NT; ++t)
#pragma unroll
        for (int r = 0; r < 4; ++r) { const float lg = st[t][r] + bp[-(16 * t + r)]; st[t][r] = lg; mx = fmaxf(mx, lg); }
    mx = fmaxf(mx, shfl_x(mx, 16, lane)); mx = fmaxf(mx, shfl_x(mx, 32, lane));
    float sum = 0.f;
#pragma unroll
    for (int t = 0; t < NT; ++t)
#pragma unroll
        for (int r = 0; r < 4; ++r) { const float p = __builtin_amdgcn_exp2f(st[t][r] - mx); st[t][r] = p; sum += p; }
    sum += shfl_x(sum, 16, lane); sum += shfl_x(sum, 32, lane);
    if (KVC_RIDE == 4) asm volatile("s_waitcnt vmcnt(4)" ::: "memory"); else if (KVC_RIDE == 6) asm volatile("s_waitcnt vmcnt(6)" ::: "memory"); else asm volatile("s_waitcnt vmcnt(0)" ::: "memory");
    __builtin_amdgcn_s_barrier(); asm volatile("" ::: "memory");
    pg8::f32x4 o[8];
#pragma unroll
    for (int dt = 0; dt < 8; ++dt) o[dt] = (pg8::f32x4){0.f, 0.f, 0.f, 0.f};
    {
        s16x4 vlo[2][4], vhi[2][4];
#define ATT_LDV(buf, h_) do { const int ra_ = kkb + 32 * ((h_) >> 1) + 4 * gq + (q >> 2); const LAS unsigned char* va_ = Vl + ra_ * 256 + (lane & 3) * 8; \
            _Pragma("unroll") for (int d_ = 0; d_ < 4; ++d_) { const int sw_ = ((4 * ((h_) & 1) + d_) ^ (ra_ & 7)) << 5; vlo[buf][d_] = tr16(va_ + sw_); vhi[buf][d_] = tr16(va_ + 16 * 256 + sw_); } } while (0)
        ATT_LDV(0, 0);
#pragma unroll
        for (int hs = 0; hs < NT; ++hs) {
            if (hs + 1 < NT) ATT_LDV((hs + 1) & 1, hs + 1);
            const int s = hs >> 1;
            const unsigned p0 = pk2(st[2 * s][0], st[2 * s][1]), p1 = pk2(st[2 * s][2], st[2 * s][3]), p2 = pk2(st[2 * s + 1][0], st[2 * s + 1][1]), p3 = pk2(st[2 * s + 1][2], st[2 * s + 1][3]);
            const bf16x8 pf = __builtin_bit_cast(bf16x8, (u32x4){p0, p1, p2, p3});
            __builtin_amdgcn_sched_barrier(0);
#pragma unroll
            for (int d = 0; d < 4; ++d) {
                const s16x4 lo = vlo[hs & 1][d], hi = vhi[hs & 1][d];
                const bf16x8 vf = (bf16x8){lo[0], lo[1], lo[2], lo[3], hi[0], hi[1], hi[2], hi[3]};
                o[4 * (hs & 1) + d] = mfma16(vf, pf, o[4 * (hs & 1) + d]);
            }
            __builtin_amdgcn_sched_barrier(0);
        }
#undef ATT_LDV
    }
    const float inv = 1.0f / sum;
#pragma unroll
    for (int dt = 0; dt < 8; ++dt) *(u32x2*)(orow + 16 * dt) = (u32x2){pk2(o[dt][0] * inv, o[dt][1] * inv), pk2(o[dt][2] * inv, o[dt][3] * inv)};
    if (gq == 0) *lsep = mx + __builtin_amdgcn_logf(sum);
#pragma unroll
    for (int j = 0; j < KVC_RIDE; ++j) { const f32x4* sp; f32x4* dp; kvc_map1(A, outp, cgrp, cbase + j * 512, sp, dp); __builtin_nontemporal_store(cv[j], dp); }
}
__device__ __forceinline__ void attn_phase(const Frame& F, int l) {
    const KArgs A = kargs();
    const int wave = F.wave;
    bf16* OG = (bf16*)(F.ws + WS_OG); float* LSE = (float*)(F.ws + WS_LSE);
    LAS unsigned char* Kl = F.lds; LAS unsigned char* Vl = F.lds + 65536; LAS float* biasP = (LAS float*)(F.lds + LDSBIAS_OFF);
    u32x4 kreg[8]; bf16x8 qn[4];
    if (F.vcu < 1536) { const AttnU u0 = attn_decode(F.vcu); attn_request(F, u0, F.tid, wave, kreg, qn); }
    const bool fixed_h = (F.G & 31) == 0;
    if (fixed_h) {
        const int h = F.vcu & 7;
        for (int e = F.tid; e < 3 * 448; e += 512) { const int g = e / 448, i = e - g * 448, du = i - 160, dil = g == 0 ? 1 : (g == 1 ? 4 : 16);
            biasP[e] = (du >= 0 && du <= 128) ? KIN(A, RELB)[t5_bucket(du * dil) * 24 + g * 8 + h] * LOG2E : -1e30f; }
    }
#pragma unroll 1
    for (int id = F.vcu; id < 1536; id += F.G) {
        int tid_ = F.tid; asm volatile("" : "+v"(tid_));
        const int tid = tid_, lane = tid & 63;
        const AttnU u = attn_decode(id);
        const int dil = u.g == 0 ? 1 : (u.g == 1 ? 4 : 16), gh = u.g * 8 + u.h, kk_lo = (u.n == 0) ? 128 : 0, npass = (256 - kk_lo) >> 5;
        {
            const int c16 = tid & 15, rr = tid >> 4;
            if (!fixed_h && tid < 448) { const int du = tid - 160; biasP[u.g * 448 + tid] = (du >= 0 && du <= 128) ? KIN(A, RELB)[t5_bucket(du * dil) * 24 + gh] * LOG2E : -1e30f; }
#pragma unroll
            for (int p = 0; p < 8; ++p) if (p < npass) {
                const int kk = kk_lo + 32 * p + rr;
                *(LAS u32x4*)(Kl + kk * 256 + ((c16 ^ (kk & 15)) << 4)) = kreg[p];
            }
        }
        bf16x8 qf[4];
#pragma unroll
        for (int ks = 0; ks < 4; ++ks) qf[ks] = qn[ks];
        {
            const bf16* V = (const bf16*)(F.ws + WS_V);
#pragma unroll
            for (int j = 0; j < 8; ++j) if (j < npass) {
                const int kk0 = kk_lo + 4 * (wave * npass + j), row = kk0 + (lane >> 4), sl = lane & 15, c16 = ((((sl >> 1) ^ (row & 7)) << 1) | (sl & 1));
                const bf16* gsrc = V + ((size_t)(u.b * TT + (128 * (u.n - 1) + row) * dil + u.cls)) * QKVW + gh * 128 + c16 * 8;
                __builtin_amdgcn_global_load_lds((const unsigned*)gsrc, (LAS unsigned*)(Vl + kk0 * 256), 16, 0, 0);
            }
        }
        asm volatile("s_waitcnt lgkmcnt(0)" ::: "memory"); __builtin_amdgcn_s_barrier(); asm volatile("" ::: "memory");
        if (id + F.G < 1536) { const AttnU un = attn_decode(id + F.G); attn_request(F, un, tid, wave, kreg, qn); }
        const int iq = 16 * wave + (lane & 15);
        const size_t qrow = (size_t)(u.b * TT + (128 * u.n + iq) * dil + u.cls);
        bf16* orow = OG + ((size_t)u.g * MPAD + qrow) * ATTW + u.h * 128 + 4 * (lane >> 4);
        float* lsep = LSE + ((size_t)u.g * MPAD + qrow) * 8 + u.h;
        f32x4 cv[KVC_RIDE > 0 ? KVC_RIDE : 1];
        const int cbase = l * KVC_LQ + KVC_LAYER + id * (512 * KVC_RIDE) + tid;
        const int cgrp = l == 0 ? 1 : 2;
        __builtin_amdgcn_sched_barrier(0);
#pragma unroll
        for (int j = 0; j < KVC_RIDE; ++j) { const f32x4* sp; f32x4* dp; kvc_map1(A, F.out, cgrp, cbase + j * 512, sp, dp); cv[j] = __builtin_nontemporal_load(sp); }
        __builtin_amdgcn_sched_barrier(0);
        if (u.n != 0) attn_compute<10>(Kl, Vl, biasP + u.g * 448, qf, 32 * (wave >> 1), iq, lane, orow, lsep, cv, A, F.out, cbase, cgrp);
        else attn_compute<8>(Kl, Vl, biasP + u.g * 448, qf, 128, iq, lane, orow, lsep, cv, A, F.out, cbase, cgrp);
        asm volatile("s_waitcnt lgkmcnt(0)" ::: "memory"); __builtin_amdgcn_s_barrier(); asm volatile("" ::: "memory");
    }
    __syncthreads();
}

__device__ __forceinline__ void attn_sample_task(const Frame& F, int l, int task) {
    const KArgs A = kargs();
    const float* relb = KIN(A, RELB);
    int lane_ = F.lane; asm volatile("" : "+v"(lane_));
    const int lane = lane_, s = task & 3, gh = (task >> 2) % 24, bs = task / 96, g = gh >> 3, h = gh & 7;
    const int dil = g == 0 ? 1 : (g == 1 ? 4 : 16), Wg = g == 0 ? 128 : (g == 1 ? 512 : 2048);
    const float* cache = (g == 0 ? KIN(A, C0) : (g == 1 ? KIN(A, C1) : KIN(A, C2))) + ((size_t)(l * NB_S + bs) * Wg) * KVROW + h * 128;
    const float* fresh = (const float*)F.out + (g == 0 ? O_KVS0 : (g == 1 ? O_KVS1 : O_KVS2)) + ((size_t)(l * NB_S + bs) * Wg) * KVROW + h * 128;
    const int row = MP + bs * 4 + s, hl = lane >> 5, d4 = (lane & 31) * 4;
    const bf16* Q = (const bf16*)(F.ws + WS_Q);
    const u32x2 qw = *(const u32x2*)(Q + (size_t)row * QKVW + gh * 128 + d4);
    const f32x4 q4 = (f32x4){bflo(qw.x), bfhi(qw.x), bflo(qw.y), bfhi(qw.y)};
    float mx = -1e30f, sum = 0.f; f32x4 acc = (f32x4){0.f, 0.f, 0.f, 0.f};
#pragma unroll 1
    for (int jb = 0; jb < 65; jb += 13) {
        f32x4 kv[13], vv[13]; float bsv[13];
#pragma unroll
        for (int u = 0; u < 13; ++u) {
            const int j = 2 * (jb + u) + hl, jc = j <= 128 ? j : 0, idx = Wg + s - jc * dil;
            const float* rowp = (idx < Wg ? cache + (size_t)idx * KVROW : fresh + (size_t)(idx - 4) * KVROW) + d4;
            kv[u] = *(const f32x4*)rowp; vv[u] = *(const f32x4*)(rowp + 1024); bsv[u] = relb[t5_bucket(jc * dil) * 24 + gh];
        }
        float lg[13], bm = -1e30f;
#pragma unroll
        for (int u = 0; u < 13; ++u) {
            const int j = 2 * (jb + u) + hl;
            float d = (kv[u][0] * q4[0] + kv[u][1] * q4[1]) + (kv[u][2] * q4[2] + kv[u][3] * q4[3]);
#pragma unroll
            for (int o = 1; o < 32; o <<= 1) d += shfl_x(d, o, lane);
            lg[u] = j <= 128 ? d + bsv[u] * LOG2E : -1e30f; bm = fmaxf(bm, lg[u]);
        }
        bm = fmaxf(bm, shfl_x(bm, 32, lane));
        const float mn = fmaxf(mx, bm), sc = __builtin_amdgcn_exp2f(mx - mn);
        acc = acc * sc; sum *= sc; mx = mn;
#pragma unroll
        for (int u = 0; u < 13; ++u) { const float p = __builtin_amdgcn_exp2f(lg[u] - mn); sum += p; acc += p * vv[u]; }
    }
    sum += shfl_x(sum, 32, lane);
#pragma unroll
    for (int e = 0; e < 4; ++e) acc[e] += shfl_x(acc[e], 32, lane);
    const float inv = 1.0f / sum;
    if (lane < 32) *(u32x2*)((bf16*)(F.ws + WS_OG) + ((size_t)g * MPAD + row) * ATTW + h * 128 + d4) = (u32x2){pk2(acc[0] * inv, acc[1] * inv), pk2(acc[2] * inv, acc[3] * inv)};
    if (lane == 0) ((float*)(F.ws + WS_LSE))[((size_t)g * MPAD + row) * 8 + h] = mx + __builtin_amdgcn_logf(sum);
}

__device__ __forceinline__ float one_minus_sq_exp(float x2, float a) {
    const float pser = -x2 * (1.0f + x2 * (0.5f + x2 * (0.16666667f + x2 * (0.041666668f + x2 * (0.0083333338f + x2 * 0.0013888889f)))));
    return x2 > -0.25f ? pser : 1.0f - a * a;
}
__device__ __forceinline__ void lru_unit(const Frame& F, int l, int b, int nb, int js, int uid) {
    const KArgs A = kargs();
    int tid_ = F.tid; asm volatile("" : "+v"(tid_));
    const int tid = tid_, lane = tid & 63, wave = F.wave, c0 = nb * 128, q = lane & 15, gq = lane >> 4;
    const bf16* XL = (const bf16*)(F.ws + WS_XL); const bf16* ZL = (const bf16*)(F.ws + WS_ZL); bf16* AL = (bf16*)(F.ws + WS_AL);
    LAS unsigned char* wl = F.lds + 65536;
    LAS float* wtot = (LAS float*)(F.lds + 65536 + 16384);
#pragma unroll
    for (int i = 0; i < 2; ++i) {
        const int ci = tid + 512 * i, dr = ci >> 4, ch = ci & 15;
        const bf16* src = (const bf16*)(F.ws + (dr < 32 ? WS_WR : WS_WI)) + ((size_t)(l * 16 + nb) * 128 + js * 32 + (dr & 31)) * 128 + 8 * ch;
        *(LAS u32x4*)(wl + dr * 256 + ((ch ^ (dr & 15)) << 4)) = *(const u32x4*)src;
    }
    float br[2], bi[2], sp8[2], carry[2];
#pragma unroll
    for (int cc = 0; cc < 2; ++cc) {
        const int ch = l * DM + c0 + js * 32 + 16 * cc + q;
        br[cc] = KIN(A, BR)[ch]; bi[cc] = KIN(A, BI)[ch]; sp8[cc] = 8.0f * log1pf(__expf(-KIN(A, LAM)[ch])); carry[cc] = 0.f;
    }
    const int tg = tid >> 4, chn = tid & 15;
    float cw[4][8], cb[8];
#pragma unroll
    for (int tap = 0; tap < 4; ++tap) { const f32x4 a = *(const f32x4*)(KIN(A, CONVW) + (size_t)(l * 4 + tap) * DM + c0 + 8 * chn), bq = *(const f32x4*)(KIN(A, CONVW) + (size_t)(l * 4 + tap) * DM + c0 + 8 * chn + 4);
        cw[tap][0] = a[0]; cw[tap][1] = a[1]; cw[tap][2] = a[2]; cw[tap][3] = a[3]; cw[tap][4] = bq[0]; cw[tap][5] = bq[1]; cw[tap][6] = bq[2]; cw[tap][7] = bq[3]; }
    { const f32x4 a = *(const f32x4*)(KIN(A, CONVB) + l * DM + c0 + 8 * chn), bq = *(const f32x4*)(KIN(A, CONVB) + l * DM + c0 + 8 * chn + 4);
      cb[0] = a[0]; cb[1] = a[1]; cb[2] = a[2]; cb[3] = a[3]; cb[4] = bq[0]; cb[5] = bq[1]; cb[6] = bq[2]; cb[7] = bq[3]; }
    u32x4 xw[7];
#define LRU_LOADX(ckk) do { _Pragma("unroll") for (int i = 0; i < 7; ++i) { const int t = (ckk) * 128 + 4 * tg - 3 + i; xw[i] = (u32x4){0u, 0u, 0u, 0u}; \
        if (t >= 0) xw[i] = *(const u32x4*)(XL + (size_t)(b * TT + t) * DM + c0 + 8 * chn); } } while (0)
    LRU_LOADX(0);
#pragma unroll 1
    for (int ck = 0; ck < 16; ++ck) {
        const int t0 = ck * 128;
        LAS unsigned char* xcL = F.lds + (ck & 1) * 32768;
        LAS float* wt = wtot + (ck & 1) * 512;
        {
            float x[7][8];
#pragma unroll
            for (int i = 0; i < 7; ++i) {
                const u32x4 w = xw[i];
                x[i][0] = bflo(w.x); x[i][1] = bfhi(w.x); x[i][2] = bflo(w.y); x[i][3] = bfhi(w.y); x[i][4] = bflo(w.z); x[i][5] = bfhi(w.z); x[i][6] = bflo(w.w); x[i][7] = bfhi(w.w);
            }
#pragma unroll
            for (int tt = 0; tt < 4; ++tt) {
                float y[8];
#pragma unroll
                for (int e = 0; e < 8; ++e) y[e] = cb[e] + ((cw[0][e] * x[tt][e] + cw[1][e] * x[tt + 1][e]) + (cw[2][e] * x[tt + 2][e] + cw[3][e] * x[tt + 3][e]));
                const int tok = 4 * tg + tt;
                *(LAS u32x4*)(xcL + tok * 256 + ((chn ^ (tok & 15)) << 4)) = (u32x4){pk2(y[0], y[1]), pk2(y[2], y[3]), pk2(y[4], y[5]), pk2(y[6], y[7])};
            }
        }
        __syncthreads();
        if (ck + 1 < 16) LRU_LOADX(ck + 1);
        f32x4 rv[KVC_LRIDE > 0 ? KVC_LRIDE : 1];
        const int rbase = l * KVC_LQ + KVC_LAYER + KVC_ATT + (uid * 16 + ck) * (512 * KVC_LRIDE) + tid, rgrp = l == 0 ? 1 : 2;
#pragma unroll
        for (int j = 0; j < KVC_LRIDE; ++j) { const f32x4* sp; f32x4* dp; kvc_map1(A, F.out, rgrp, rbase + j * 512, sp, dp); rv[j] = __builtin_nontemporal_load(sp); }
        bf16 zraw[2][4];
#pragma unroll
        for (int cc = 0; cc < 2; ++cc)
#pragma unroll
            for (int r = 0; r < 4; ++r) zraw[cc][r] = ZL[(size_t)(b * TT + t0 + 16 * wave + 4 * gq + r) * DM + c0 + js * 32 + 16 * cc + q];
        pg8::f32x4 acc[4];
        {
            const int tok = 16 * wave + q;
            bf16x8 af[4], bw[2][4];
#pragma unroll
            for (int ks = 0; ks < 4; ++ks) af[ks] = *(const LAS bf16x8*)(xcL + tok * 256 + (((4 * ks + gq) ^ (tok & 15)) << 4));
#pragma unroll
            for (int np = 0; np < 2; ++np) {
#pragma unroll
                for (int j = 0; j < 2; ++j)
#pragma unroll
                    for (int ks = 0; ks < 4; ++ks) bw[j][ks] = *(const LAS bf16x8*)(wl + (32 * np + 16 * j + q) * 256 + (((4 * ks + gq) ^ q) << 4));
                __builtin_amdgcn_sched_barrier(0);
#pragma unroll
                for (int j = 0; j < 2; ++j) { acc[2 * np + j] = (pg8::f32x4){0.f, 0.f, 0.f, 0.f};
#pragma unroll
                    for (int ks = 0; ks < 4; ++ks) acc[2 * np + j] = mfma16(af[ks], bw[j][ks], acc[2 * np + j]); }
                __builtin_amdgcn_sched_barrier(0);
            }
        }
        float pp[2][4], sv[2][4], Pex[2], Sex[2];
#pragma unroll
        for (int cc = 0; cc < 2; ++cc) {
            const int cidx = js * 32 + 16 * cc + q;
            float a[4], u[4];
#pragma unroll
            for (int r = 0; r < 4; ++r) {
                const int tok = 16 * wave + 4 * gq + r;
                const float xv = bf1(*(const LAS bf16*)(xcL + tok * 256 + (((cidx >> 3) ^ (tok & 15)) << 4) + (cidx & 7) * 2));
                const float rg = sigm(acc[cc][r] + br[cc]), ig = sigm(acc[2 + cc][r] + bi[cc]);
                const float la = -sp8[cc] * rg;
                a[r] = __expf(la); u[r] = __builtin_amdgcn_sqrtf(one_minus_sq_exp(2.0f * la, a[r])) * (ig * xv);
            }
            pp[cc][0] = a[0]; sv[cc][0] = u[0];
#pragma unroll
            for (int r = 1; r < 4; ++r) { pp[cc][r] = pp[cc][r - 1] * a[r]; sv[cc][r] = a[r] * sv[cc][r - 1] + u[r]; }
            float P = pp[cc][3], S = sv[cc][3];
            { const float Pn = shfl_u(P, 16, lane), Sn = shfl_u(S, 16, lane); if (gq >= 1) { S = P * Sn + S; P = P * Pn; } }
            { const float Pn = shfl_u(P, 32, lane), Sn = shfl_u(S, 32, lane); if (gq >= 2) { S = P * Sn + S; P = P * Pn; } }
            { const float Pn = shfl_u(P, 16, lane), Sn = shfl_u(S, 16, lane); Pex[cc] = gq >= 1 ? Pn : 1.0f; Sex[cc] = gq >= 1 ? Sn : 0.0f; }
            if (gq == 3) { wt[(wave * 2 + cc) * 32 + 2 * q] = P; wt[(wave * 2 + cc) * 32 + 2 * q + 1] = S; }
        }
        __syncthreads();
#pragma unroll
        for (int cc = 0; cc < 2; ++cc) {
            float hin = carry[cc], hall = carry[cc];
#pragma unroll
            for (int w = 0; w < 8; ++w) {
                const float P = wt[(w * 2 + cc) * 32 + 2 * q], S = wt[(w * 2 + cc) * 32 + 2 * q + 1];
                hall = P * hall + S; if (w < wave) hin = hall;
            }
            carry[cc] = hall;
            const float hl = Pex[cc] * hin + Sex[cc];
            const int ch = c0 + js * 32 + 16 * cc + q;
#pragma unroll
            for (int r = 0; r < 4; ++r) {
                const float hv = pp[cc][r] * hl + sv[cc][r];
                const size_t ro = (size_t)(b * TT + t0 + 16 * wave + 4 * gq + r) * DM + ch;
                AL[ro] = (bf16)(pk2(hv * bf1(zraw[cc][r]), 0.f) & 0xffffu);
                if (ck == 15 && wave == 7 && gq == 3 && r == 3) F.out[O_HP + (size_t)(l * NB_P + b) * DM + ch] = hv;
            }
        }
#pragma unroll
        for (int j = 0; j < KVC_LRIDE; ++j) { const f32x4* sp; f32x4* dp; kvc_map1(A, F.out, rgrp, rbase + j * 512, sp, dp); __builtin_nontemporal_store(rv[j], dp); }
    }
#undef LRU_LOADX
    __syncthreads();
}
__device__ __forceinline__ void lru_sample_unit(const Frame& F, int l, int bs, int nb, int dq) {
    const KArgs A = kargs();
    int tid_ = F.tid; asm volatile("" : "+v"(tid_));
    const int tid = tid_, lane = tid & 63, c0 = nb * 128;
    LAS float* xc = (LAS float*)F.lds;
    const bf16* XL = (const bf16*)(F.ws + WS_XL);
    {
        const int t = tid >> 7, c = tid & 127;
        const float cb = KIN(A, CONVB)[l * DM + c0 + c];
        float xv[2][4], cw[4];
#pragma unroll
        for (int tap = 0; tap < 4; ++tap) {
            const int p = t + tap;
            cw[tap] = KIN(A, CONVW)[(size_t)(l * 4 + tap) * DM + c0 + c];
#pragma unroll
            for (int h = 0; h < 2; ++h) { const int bb = bs + 4 * h;
                xv[h][tap] = p < 3 ? KIN(A, SCONV)[((size_t)(l * NB_S + bb) * 3 + p) * DM + c0 + c] : bf1(XL[(size_t)(MP + bb * 4 + (p - 3)) * DM + c0 + c]); }
        }
#pragma unroll
        for (int h = 0; h < 2; ++h) { float y = cb;
#pragma unroll
            for (int tap = 0; tap < 4; ++tap) y += cw[tap] * xv[h][tap];
            xc[h * 512 + t * 128 + c] = y; }
    }
    const int cq = tid & 3, t = (tid >> 2) & 3, d = dq * 32 + (tid >> 4), chg = l * DM + c0 + d;
    const bf16* wr = (const bf16*)(F.ws + WS_WR) + ((size_t)(l * 16 + nb) * 128 + d) * 128 + 32 * cq;
    const bf16* wi = (const bf16*)(F.ws + WS_WI) + ((size_t)(l * 16 + nb) * 128 + d) * 128 + 32 * cq;
    u32x4 wrv[4], wiv[4];
#pragma unroll
    for (int i = 0; i < 4; ++i) { wrv[i] = *(const u32x4*)(wr + 8 * i); wiv[i] = *(const u32x4*)(wi + 8 * i); }
    const float brv = KIN(A, BR)[chg], biv = KIN(A, BI)[chg], sp8 = 8.0f * log1pf(__expf(-KIN(A, LAM)[chg]));
    float h0[2], zv[2]; size_t ro[2];
#pragma unroll
    for (int h = 0; h < 2; ++h) { const int bb = bs + 4 * h;
        h0[h] = KIN(A, SH)[(size_t)(l * NB_S + bb) * DM + c0 + d];
        ro[h] = (size_t)(MP + bb * 4 + t) * DM + c0 + d;
        zv[h] = bf1(((const bf16*)(F.ws + WS_ZL))[ro[h]]); }
    __syncthreads();
#pragma unroll
    for (int h = 0; h < 2; ++h) {
        const LAS float* xh = xc + h * 512;
        float rp = 0.f, ip = 0.f;
#pragma unroll
        for (int i = 0; i < 4; ++i) {
            const f32x4 xa = *(const LAS f32x4*)(xh + t * 128 + 32 * cq + 8 * i), xb = *(const LAS f32x4*)(xh + t * 128 + 32 * cq + 8 * i + 4);
            rp += (xa[0] * bflo(wrv[i].x) + xa[1] * bfhi(wrv[i].x)) + (xa[2] * bflo(wrv[i].y) + xa[3] * bfhi(wrv[i].y)) + (xb[0] * bflo(wrv[i].z) + xb[1] * bfhi(wrv[i].z)) + (xb[2] * bflo(wrv[i].w) + xb[3] * bfhi(wrv[i].w));
            ip += (xa[0] * bflo(wiv[i].x) + xa[1] * bfhi(wiv[i].x)) + (xa[2] * bflo(wiv[i].y) + xa[3] * bfhi(wiv[i].y)) + (xb[0] * bflo(wiv[i].z) + xb[1] * bfhi(wiv[i].z)) + (xb[2] * bflo(wiv[i].w) + xb[3] * bfhi(wiv[i].w));
        }
        rp += shfl_x(rp, 1, lane); rp += shfl_x(rp, 2, lane); ip += shfl_x(ip, 1, lane); ip += shfl_x(ip, 2, lane);
        const float rg = sigm(rp + brv), ig = sigm(ip + biv), la = -sp8 * rg;
        float P = __expf(la), S = __builtin_amdgcn_sqrtf(one_minus_sq_exp(2.0f * la, P)) * (ig * xh[t * 128 + d]);
        { const float Pn = shfl_u(P, 4, lane), Sn = shfl_u(S, 4, lane); if (t >= 1) { S = P * Sn + S; P = P * Pn; } }
        { const float Pn = shfl_u(P, 8, lane), Sn = shfl_u(S, 8, lane); if (t >= 2) { S = P * Sn + S; P = P * Pn; } }
        const float hv = P * h0[h] + S;
        if (cq == 0) {
            ((bf16*)(F.ws + WS_AL))[ro[h]] = (bf16)(pk2(hv * zv[h], 0.f) & 0xffffu);
            if (t == 3) F.out[O_HS + (size_t)(l * NB_S + bs + 4 * h) * DM + c0 + d] = hv;
        }
    }
    __syncthreads();
}
#ifndef PROBE_SUB
#define PROBE_SUB 0
#endif
__device__ __forceinline__ void phase_mix(const Frame& F, int l) {
#pragma unroll 1
    for (int rep = 0; rep < (PROBE_SUB == 1 ? 2 : 1); ++rep) attn_phase(F, l);
#pragma unroll 1
    for (int rep = 0; rep < (PROBE_SUB == 2 ? 2 : 1); ++rep)
#pragma unroll 1
        for (int id = F.vcu; id < 256; id += F.G) lru_unit(F, l, id >> 6, (id >> 2) & 15, id & 3, id);
#pragma unroll 1
    for (int rep = 0; rep < (PROBE_SUB == 3 ? 2 : 1); ++rep) {
#pragma unroll 1
        for (int id = F.vcu; id < 256; id += F.G) lru_sample_unit(F, l, id >> 6, (id >> 2) & 15, id & 3);
        if (F.wave < 3) { for (int task = F.vcu * 3 + F.wave; task < 768; task += F.G * 3) attn_sample_task(F, l, task); }
        else kvcopy_range(F, l * KVC_LQ, l * KVC_LQ + KVC_LAYER, (F.vcu * 5 + (F.wave - 3)) * 64 + F.lane, F.G * 320);
        __syncthreads();
    }
}
typedef float f32x16 __attribute__((ext_vector_type(16)));
typedef float f32x2v __attribute__((ext_vector_type(2)));
template <int K, int LD, int NB, class Epi>
__device__ __forceinline__ void thin_gemm(const Frame& F, const bf16* A, const bf16* Bt, int N, const Epi& E) {
    int tid_ = F.tid; asm volatile("" : "+v"(tid_));
    const int tid = tid_, lane = tid & 63, wave = F.wave, r32 = lane & 31, hh = lane >> 5;
    constexpr int KS = K / 8, CH = 32, NCH = KS / CH, ROWS = 32 * (NB + 1), NI = ROWS / 16, BUFB = ROWS * 64, NBUF = (16384 / BUFB) < NCH ? (16384 / BUFB) : NCH;
    static_assert(NBUF >= 2 && NBUF * BUFB <= 16384 && NCH * CH == KS, "thin_gemm staging");
    __builtin_amdgcn_s_waitcnt(0x0F70);
    LAS float* part = (LAS float*)F.lds;
    LAS unsigned char* stg = F.lds + wave * 16384;
    const int rr = lane >> 2, sc = (lane & 3) ^ ((rr >> 1) & 3);
    const int rd = (r32 >> 4) * 1024 + (r32 & 15) * 64, rx = ((r32 & 15) >> 1) & 3;
#pragma unroll 1
    for (int item = F.vcu; item < N / (32 * NB); item += F.G) {
        const int n0 = item * 32 * NB;
        const GAS bf16* gw = (const GAS bf16*)Bt + (size_t)(n0 + rr) * LD + wave * KS + sc * 8;
        const GAS bf16* ga = (const GAS bf16*)A + (size_t)rr * LD + wave * KS + sc * 8;
        f32x16 acc[NB];
#pragma unroll
        for (int b = 0; b < NB; ++b)
#pragma unroll
            for (int i = 0; i < 16; ++i) acc[b][i] = 0.f;
#define THIN_STAGE(ch_) do { _Pragma("unroll") for (int j_ = 0; j_ < NI; ++j_) { \
            const GAS bf16* src_ = j_ < 2 * NB ? gw + (size_t)(16 * j_) * LD + (ch_) * CH : ga + (size_t)(16 * (j_ - 2 * NB)) * LD + (ch_) * CH; \
            __builtin_amdgcn_global_load_lds((const GAS unsigned*)src_, (LAS unsigned*)(stg + ((ch_) % NBUF) * BUFB + j_ * 1024), 16, 0, 0); } } while (0)
#pragma unroll
        for (int c = 0; c < NBUF - 1; ++c) THIN_STAGE(c);
#pragma unroll
        for (int ch = 0; ch < NCH; ++ch) {
            if (ch + NBUF - 1 < NCH) THIN_STAGE(ch + NBUF - 1);
            { constexpr int dummy = 0; (void)dummy; }
            const int ahead = (NCH - 1 - ch) < (NBUF - 1) ? (NCH - 1 - ch) : (NBUF - 1);
            if (ahead == 3) asm volatile("s_waitcnt vmcnt(%0)" :: "n"(3 * NI) : "memory");
            else if (ahead == 2) asm volatile("s_waitcnt vmcnt(%0)" :: "n"(2 * NI) : "memory");
            else if (ahead == 1) asm volatile("s_waitcnt vmcnt(%0)" :: "n"(NI) : "memory");
            else asm volatile("s_waitcnt vmcnt(0)" ::: "memory");
            const LAS unsigned char* bufp = stg + (ch % NBUF) * BUFB + rd;
            bf16x8 af[2], bf[NB][2];
#pragma unroll
            for (int ks = 0; ks < 2; ++ks) {
                const int po = ((2 * ks + hh) ^ rx) * 16;
                af[ks] = *(const LAS bf16x8*)(bufp + NB * 2048 + po);
#pragma unroll
                for (int b = 0; b < NB; ++b) bf[b][ks] = *(const LAS bf16x8*)(bufp + b * 2048 + po);
            }
            __builtin_amdgcn_sched_barrier(0);
#pragma unroll
            for (int ks = 0; ks < 2; ++ks)
#pragma unroll
                for (int b = 0; b < NB; ++b) acc[b] = __builtin_amdgcn_mfma_f32_32x32x16_bf16(af[ks], bf[b][ks], acc[b], 0, 0, 0);
            asm volatile("s_waitcnt lgkmcnt(0)" ::: "memory");
        }
#undef THIN_STAGE
        __syncthreads();
#pragma unroll
        for (int b = 0; b < NB; ++b)
#pragma unroll
            for (int reg = 0; reg < 16; ++reg) part[((wave * NB + b) * 32 + (reg & 3) + 8 * (reg >> 2) + 4 * hh) * 32 + r32] = acc[b][reg];
        __syncthreads();
        const int row = tid >> 4, c2 = (tid & 15) * 2;
#pragma unroll
        for (int b = 0; b < NB; ++b) {
            float v0 = 0.f, v1 = 0.f;
#pragma unroll
            for (int w = 0; w < 8; ++w) { const f32x2v pv = *(const LAS f32x2v*)(part + ((w * NB + b) * 32 + row) * 32 + c2); v0 += pv[0]; v1 += pv[1]; }
            E(row, n0 + b * 32 + c2, v0, v1);
        }
        __syncthreads();
    }
}
template <int K0, int K1, int LD, class Epi>
__device__ __forceinline__ void thin_gemm_pair(const Frame& F, const bf16* A0, const bf16* Bt0, const bf16* A1, const bf16* Bt1, int N, const Epi& E) {
    int tid_ = F.tid; asm volatile("" : "+v"(tid_));
    const int tid = tid_, lane = tid & 63, wave = F.wave, r32 = lane & 31, hh = lane >> 5;
    constexpr int KS0 = K0 / 8, KS1 = K1 / 8, CH = 32, NCH0 = KS0 / CH, NCH = NCH0 + KS1 / CH, NI = 4, BUFB = 64 * 64, NBUF = 4;
    static_assert(NBUF * BUFB <= 16384 && NCH0 * CH == KS0 && (NCH - NCH0) * CH == KS1 && NCH >= NBUF, "thin_gemm_pair staging");
    __builtin_amdgcn_s_waitcnt(0x0F70);
    LAS float* part = (LAS float*)F.lds;
    LAS unsigned char* stg = F.lds + wave * 16384;
    const int rr = lane >> 2, sc = (lane & 3) ^ ((rr >> 1) & 3);
    const int rd = (r32 >> 4) * 1024 + (r32 & 15) * 64, rx = ((r32 & 15) >> 1) & 3;
#pragma unroll 1
    for (int item = F.vcu; item < N / 32; item += F.G) {
        const int n0 = item * 32;
        const GAS bf16* gw0 = (const GAS bf16*)Bt0 + (size_t)(n0 + rr) * LD + wave * KS0 + sc * 8;
        const GAS bf16* ga0 = (const GAS bf16*)A0 + (size_t)rr * LD + wave * KS0 + sc * 8;
        const GAS bf16* gw1 = (const GAS bf16*)Bt1 + (size_t)(n0 + rr) * LD + wave * KS1 + sc * 8;
        const GAS bf16* ga1 = (const GAS bf16*)A1 + (size_t)rr * LD + wave * KS1 + sc * 8;
        f32x16 acc[2];
#pragma unroll
        for (int b = 0; b < 2; ++b)
#pragma unroll
            for (int i = 0; i < 16; ++i) acc[b][i] = 0.f;
#define THIN_STAGE2(ch_) do { _Pragma("unroll") for (int j_ = 0; j_ < NI; ++j_) { \
            const GAS bf16* w_ = (ch_) < NCH0 ? gw0 + (ch_) * CH : gw1 + ((ch_) - NCH0) * CH; const GAS bf16* a_ = (ch_) < NCH0 ? ga0 + (ch_) * CH : ga1 + ((ch_) - NCH0) * CH; \
            const GAS bf16* src_ = j_ < 2 ? w_ + (size_t)(16 * j_) * LD : a_ + (size_t)(16 * (j_ - 2)) * LD; \
            __builtin_amdgcn_global_load_lds((const GAS unsigned*)src_, (LAS unsigned*)(stg + ((ch_) % NBUF) * BUFB + j_ * 1024), 16, 0, 0); } } while (0)
#pragma unroll
        for (int c = 0; c < NBUF - 1; ++c) THIN_STAGE2(c);
#pragma unroll
        for (int ch = 0; ch < NCH; ++ch) {
            if (ch + NBUF - 1 < NCH) THIN_STAGE2(ch + NBUF - 1);
            const int ahead = (NCH - 1 - ch) < (NBUF - 1) ? (NCH - 1 - ch) : (NBUF - 1);
            if (ahead == 3) asm volatile("s_waitcnt vmcnt(%0)" :: "n"(3 * NI) : "memory");
            else if (ahead == 2) asm volatile("s_waitcnt vmcnt(%0)" :: "n"(2 * NI) : "memory");
            else if (ahead == 1) asm volatile("s_waitcnt vmcnt(%0)" :: "n"(NI) : "memory");
            else asm volatile("s_waitcnt vmcnt(0)" ::: "memory");
            const LAS unsigned char* bufp = stg + (ch % NBUF) * BUFB + rd;
            bf16x8 af[2], bf[2];
#pragma unroll
            for (int ks = 0; ks < 2; ++ks) { const int po = ((2 * ks + hh) ^ rx) * 16; af[ks] = *(const LAS bf16x8*)(bufp + 2048 + po); bf[ks] = *(const LAS bf16x8*)(bufp + po); }
            __builtin_amdgcn_sched_barrier(0);
#pragma unroll
            for (int ks = 0; ks < 2; ++ks) acc[ch < NCH0 ? 0 : 1] = __builtin_amdgcn_mfma_f32_32x32x16_bf16(af[ks], bf[ks], acc[ch < NCH0 ? 0 : 1], 0, 0, 0);
            asm volatile("s_waitcnt lgkmcnt(0)" ::: "memory");
        }
#undef THIN_STAGE2
        __syncthreads();
#pragma unroll
        for (int b = 0; b < 2; ++b)
#pragma unroll
            for (int reg = 0; reg < 16; ++reg) part[((wave * 2 + b) * 32 + (reg & 3) + 8 * (reg >> 2) + 4 * hh) * 32 + r32] = acc[b][reg];
        __syncthreads();
        const int row = tid >> 4, c2 = (tid & 15) * 2;
        float v[2][2] = {{0.f, 0.f}, {0.f, 0.f}};
#pragma unroll
        for (int b = 0; b < 2; ++b)
#pragma unroll
            for (int w = 0; w < 8; ++w) { const f32x2v pv = *(const LAS f32x2v*)(part + ((w * 2 + b) * 32 + row) * 32 + c2); v[b][0] += pv[0]; v[b][1] += pv[1]; }
        E(row, n0 + c2, v[0][0], v[0][1], v[1][0], v[1][1]);
        __syncthreads();
    }
}
struct ThinIn {
    bf16 *Q, *K, *V, *ZA, *XL, *ZL, *GA, *GL; GAS float* out; int l;
    __device__ __forceinline__ void operator()(int r, int c, float v0, float v1) const {
        const size_t row = MP + r; const int bs = r >> 2, s = r & 3;
        if (c < C_K) { *(unsigned*)(Q + row * QKVW + c) = pk2(v0 * QSCALE, v1 * QSCALE); }
        else if (c < C_ZA) {
            const int which = c < C_V ? 1 : 2, cc = c - which * QKVW, gi = cc >> 10, Wg = gi == 0 ? 128 : (gi == 1 ? 512 : 2048);
            *(unsigned*)((which == 1 ? K : V) + row * QKVW + cc) = pk2(v0, v1);
            GAS float* dst = out + (gi == 0 ? O_KVS0 : (gi == 1 ? O_KVS1 : O_KVS2)) + (((size_t)(l * NB_S + bs) * Wg + (Wg - 4 + s)) * 2 + (which - 1)) * 1024 + (cc & 1023);
            dst[0] = v0; dst[1] = v1;
        }
        else if (c < C_XL) { *(unsigned*)(ZA + row * ATTW + (c - C_ZA)) = pk2(v0, v1); }
        else if (c < C_ZL) {
            *(unsigned*)(XL + row * DM + (c - C_XL)) = pk2(v0, v1);
            if (s >= 1) { GAS float* dst = out + O_CVS + ((size_t)(l * NB_S + bs) * 3 + (s - 1)) * DM + (c - C_XL); dst[0] = v0; dst[1] = v1; }
        }
        else if (c < C_GA) { *(unsigned*)(ZL + row * DM + (c - C_ZL)) = pk2(v0 * sigm(v0), v1 * sigm(v1)); }
        else if (c < C_GL) { *(unsigned*)(GA + row * DM + (c - C_GA)) = pk2(sigm(v0), sigm(v1)); }
        else { *(unsigned*)(GL + row * DM + (c - C_GL)) = pk2(sigm(v0), sigm(v1)); }
    }
};
struct ThinPA { const bf16* GA; bf16* TMP;
    __device__ __forceinline__ void operator()(int r, int c, float v0, float v1) const { const size_t o = (size_t)(MP + r) * DM + c; const unsigned g = *(const unsigned*)(GA + o); *(unsigned*)(TMP + o) = pk2(v0 * bflo(g), v1 * bfhi(g)); } };
struct ThinPB { const bf16* GL; const bf16* TMP; bf16* MG;
    __device__ __forceinline__ void operator()(int r, int c, float v0, float v1) const { const size_t o = (size_t)(MP + r) * DM + c; const unsigned g = *(const unsigned*)(GL + o), tw = *(const unsigned*)(TMP + o); *(unsigned*)(MG + o) = pk2(bflo(tw) + v0 * bflo(g), bfhi(tw) + v1 * bfhi(g)); } };
struct ThinPAB { const bf16* GA; const bf16* GL; bf16* MG;
    __device__ __forceinline__ void operator()(int r, int c, float a0, float a1, float l0, float l1) const { const size_t o = (size_t)(MP + r) * DM + c; const unsigned ga = *(const unsigned*)(GA + o), gl = *(const unsigned*)(GL + o);
        *(unsigned*)(MG + o) = pk2(a0 * bflo(ga) + l0 * bflo(gl), a1 * bfhi(ga) + l1 * bfhi(gl)); } };
struct ThinOut { const float* xs; float* X; const float* mod; int l;
    __device__ __forceinline__ void operator()(int r, int c, float v0, float v1) const {
        const size_t o = (size_t)(MP + r) * DM + c; const float* gp = mod + (size_t)(l * NMODB + NB_P + (r >> 2)) * 6144 + 4096 + c;
        const float x0 = l == 0 ? xs[(size_t)r * DM + c] : X[o], x1 = l == 0 ? xs[(size_t)r * DM + c + 1] : X[o + 1];
        X[o] = x0 + gp[0] * v0; X[o + 1] = x1 + gp[1] * v1; } };
struct MergeRow { float l0, l1, l2; u32x4 a[2], b[2], c[2], z[2]; };
__device__ __forceinline__ void merge_load(const Frame& F, int r, int lane, MergeRow& m) {
    const bf16* OG = (const bf16*)(F.ws + WS_OG); const float* LSE = (const float*)(F.ws + WS_LSE); const bf16* ZA = (const bf16*)(F.ws + WS_ZA);
    const int h = lane >> 3;
    m.l0 = LSE[((size_t)0 * MPAD + r) * 8 + h]; m.l1 = LSE[((size_t)1 * MPAD + r) * 8 + h]; m.l2 = LSE[((size_t)2 * MPAD + r) * 8 + h];
#pragma unroll
    for (int hf = 0; hf < 2; ++hf) {
        const size_t co = (size_t)r * ATTW + lane * 16 + hf * 8;
        m.a[hf] = *(const u32x4*)(OG + co); m.b[hf] = *(const u32x4*)(OG + (size_t)MPAD * ATTW + co); m.c[hf] = *(const u32x4*)(OG + (size_t)2 * MPAD * ATTW + co); m.z[hf] = *(const u32x4*)(ZA + co);
    }
}
__device__ __forceinline__ void merge_store(const Frame& F, int r, int lane, const MergeRow& m) {
    bf16* AA = (bf16*)(F.ws + WS_AA);
    const float mx = fmaxf(m.l0, fmaxf(m.l1, m.l2));
    float w0 = __builtin_amdgcn_exp2f(m.l0 - mx), w1 = __builtin_amdgcn_exp2f(m.l1 - mx), w2 = __builtin_amdgcn_exp2f(m.l2 - mx);
    const float inv = __builtin_amdgcn_rcpf(w0 + w1 + w2); w0 *= inv; w1 *= inv; w2 *= inv;
#pragma unroll
    for (int hf = 0; hf < 2; ++hf) {
        u32x4 o;
#pragma unroll
        for (int e = 0; e < 4; ++e) {
            const float zl = bflo(m.z[hf][e]), zh = bfhi(m.z[hf][e]);
            const float lo = (w0 * bflo(m.a[hf][e]) + w1 * bflo(m.b[hf][e]) + w2 * bflo(m.c[hf][e])) * (zl * sigm(zl));
            const float hi = (w0 * bfhi(m.a[hf][e]) + w1 * bfhi(m.b[hf][e]) + w2 * bfhi(m.c[hf][e])) * (zh * sigm(zh));
            o[e] = pk2(lo, hi);
        }
        *(u32x4*)(AA + (size_t)r * DM + lane * 16 + hf * 8) = o;
    }
}
__device__ __forceinline__ void phase_merge(const Frame& F) {
    const int gw = F.vcu * 8 + F.wave, NGW = F.G * 8, lane = F.lane;
#pragma unroll 1
    for (int r0 = 4 * gw; r0 < MR; r0 += 4 * NGW) {
        const int nrow = (MR - r0) < 4 ? (MR - r0) : 4;
        MergeRow cur, nxt;
        merge_load(F, r0, lane, cur);
#pragma unroll
        for (int k = 0; k < 4; ++k) if (k < nrow) {
            if (k + 1 < nrow) merge_load(F, r0 + k + 1, lane, nxt);
            merge_store(F, r0 + k, lane, cur);
            cur = nxt;
        }
    }
}

#ifndef MK_PER_PHASE
#define MK_PER_PHASE 0
#endif
constexpr int N_PHASES = 2 + 6 * DEPTH + 1;

__global__ void __launch_bounds__(512, 2) fwd_kernel(Args args) {
    extern __shared__ __attribute__((aligned(16))) unsigned char lds_raw[];
    Frame F0;
    F0.lds = (LAS unsigned char*)lds_raw;
    F0.tid = threadIdx.x; F0.lane = F0.tid & 63; F0.wave = __builtin_amdgcn_readfirstlane(F0.tid >> 6);
    F0.G = gridDim.x; { const int bx = blockIdx.x; F0.vcu = (F0.G % 8 == 0) ? (bx % 8) * (F0.G / 8) + bx / 8 : bx; }
    F0.out = (GAS float*)args.out; F0.ws = (GAS unsigned char*)args.ws;
    for (int u = F0.tid; u < 128; u += 512) ((LAS unsigned*)(F0.lds + LDSCTL_OFF))[u] = 0u;
    __syncthreads();
    unsigned* ctl = (unsigned*)(args.ws + WS_CTL);
    XcdBarrier bar = xcd_barrier_post(ctl + CW_BAR + args.li * XCD_BAR_WORDS, (volatile LAS unsigned*)(F0.lds + LDSCTL_OFF) + 8);
    const int lo = args.ph_lo, hi = args.ph_hi;
#define IN(k) (lo <= (k) && (k) < hi)
#define IS_T0() (F0.wave == 0 && hw_lane() == 0)
#ifndef PROBE_XBAR
#define PROBE_XBAR 1
#endif
#ifdef TPROBE
#define SEAM(k) do { if (IN(k) && IN((k) + 1)) { const unsigned ts0_ = (unsigned)__builtin_amdgcn_s_memrealtime(); xcd_barrier(bar, IS_T0()); const unsigned ts1_ = (unsigned)__builtin_amdgcn_s_memrealtime(); \
        if (F0.tid == 0) { __hip_atomic_fetch_add((LAS unsigned*)(F0.lds + LDSCTL_OFF) + 104, ts1_ - ts0_, __ATOMIC_RELAXED, __HIP_MEMORY_SCOPE_WORKGROUP); \
            if ((k) == TPROBE_SEAM || (TPROBE_SEAM >= 100 && (k) >= 2 && ((k) - 2) % 6 == TPROBE_SEAM - 100)) __hip_atomic_fetch_add((LAS unsigned*)(F0.lds + LDSCTL_OFF) + 105, ts1_ - ts0_, __ATOMIC_RELAXED, __HIP_MEMORY_SCOPE_WORKGROUP); } } } while (0)
#else
#define SEAM(k) do { if (IN(k) && IN((k) + 1)) { for (int xb_ = 0; xb_ < PROBE_XBAR; ++xb_) xcd_barrier(bar, IS_T0()); } } while (0)
#endif
#ifndef PROBE_REP
#define PROBE_REP (-1)
#endif
#ifndef PROBE_N
#define PROBE_N 1
#endif
#ifdef TPROBE
#ifndef TPROBE_SEAM
#define TPROBE_SEAM (-1)
#endif
#define TP_BEGIN() const unsigned tq0_ = (unsigned)__builtin_amdgcn_s_memrealtime()
#define TP_END(w) do { const unsigned tq1_ = (unsigned)__builtin_amdgcn_s_memrealtime(); if (F.tid == 0) __hip_atomic_fetch_add((LAS unsigned*)(F.lds + LDSCTL_OFF) + (w), tq1_ - tq0_, __ATOMIC_RELAXED, __HIP_MEMORY_SCOPE_WORKGROUP); } while (0)
#define TP_BEGIN2() const unsigned tr0_ = (unsigned)__builtin_amdgcn_s_memrealtime()
#define TP_END2(w) do { const unsigned tr1_ = (unsigned)__builtin_amdgcn_s_memrealtime(); if (F.tid == 0) __hip_atomic_fetch_add((LAS unsigned*)(F.lds + LDSCTL_OFF) + (w), tr1_ - tr0_, __ATOMIC_RELAXED, __HIP_MEMORY_SCOPE_WORKGROUP); } while (0)
#else
#define TP_BEGIN2() do {} while (0)
#define TP_END2(w) do {} while (0)
#define TP_BEGIN() do {} while (0)
#define TP_END(w) do {} while (0)
#endif
#define REPEAT(kind, ...) do { __VA_ARGS__ if (PROBE_REP == (kind)) { for (int rep_ = 0; rep_ < PROBE_N; ++rep_) { xcd_barrier(bar, IS_T0()); __VA_ARGS__ } } } while (0)

    #ifndef NO_P0
    if (IN(0)) REPEAT(0, { const Frame F = fresh(F0); p0_prologue(F); });
#endif
    SEAM(0);
    #ifndef NO_P1
    if (IN(1)) { const Frame F = fresh(F0); p1_modreduce(F); }
#endif
    SEAM(1);
#pragma unroll 1
    for (int l = 0; l < DEPTH; ++l) {
        const int pb = 2 + 6 * l;
#ifndef NO_PA
        if (IN(pb)) REPEAT(2, { const Frame F = fresh(F0); phase_norm(F, l); });
#endif
        SEAM(pb);
#if PROBE_REP == 7
        if (IN(pb + 1)) for (int rep_ = 0; rep_ < PROBE_N; ++rep_) {
            const Frame F = fresh(F0);
            pg8::Gemm g{(const pg8::bf16_t*)(F.ws + WS_H), (const pg8::bf16_t*)(F.ws + WS_WIN) + (size_t)l * INC * DM, MP, INC, DM};
            pg8::StaticOrder S; S.init(MP, INC, F.G, (int)blockIdx.x);
            EpiNull<true> E;
            pg8::gemm_phase<EpiNull<true>, pg8::StaticOrder, true, true>(F.lds, g, S, E, F.tid);
            xcd_barrier(bar, IS_T0());
        }
#endif
#if PROBE_REP == 8
        if (IN(pb + 1)) for (int rep_ = 0; rep_ < PROBE_N; ++rep_) {
            const Frame F = fresh(F0);
            pg8::Gemm g{(const pg8::bf16_t*)(F.ws + WS_H), (const pg8::bf16_t*)(F.ws + WS_WOUT) + (size_t)l * DM * DM, MP, DM, DM};
            pg8::StaticOrder S; S.init(MP, DM, F.G, (int)blockIdx.x);
            EpiNull<false> E;
            pg8::gemm_phase<EpiNull<false>, pg8::StaticOrder, false, true>(F.lds, g, S, E, F.tid);
            xcd_barrier(bar, IS_T0());
        }
#endif
#if PROBE_REP == 9
        if (IN(pb + 1)) for (int rep_ = 0; rep_ < PROBE_N; ++rep_) {
            const Frame F = fresh(F0);
            pg8::Gemm g0{(const pg8::bf16_t*)(F.ws + WS_H), (const pg8::bf16_t*)(F.ws + WS_WPA) + (size_t)l * DM * DM, MP, DM, ATTW};
            pg8::Gemm g1{(const pg8::bf16_t*)(F.ws + WS_H), (const pg8::bf16_t*)(F.ws + WS_WPB) + (size_t)l * DM * DM, MP, DM, DM};
            pg8::StaticOrder S; S.init(MP, DM, F.G, (int)blockIdx.x);
            EpiNull<true> E;
            pg8::gemm_chain<EpiNull<true>, pg8::StaticOrder>(F.lds, g0, g1, DM, S, E, F.tid);
            xcd_barrier(bar, IS_T0());
        }
#endif
#ifndef NO_PB
        if (IN(pb + 1)) REPEAT(3, {
            const Frame F = fresh(F0);
            pg8::Gemm g{(const pg8::bf16_t*)(F.ws + WS_H), (const pg8::bf16_t*)(F.ws + WS_WIN) + (size_t)l * INC * DM, MP, INC, DM};
            pg8::StaticOrder S; S.init(MP, INC, F.G, (int)blockIdx.x);
            EpiIn E{(bf16*)(F.ws + WS_Q), (bf16*)(F.ws + WS_K), (bf16*)(F.ws + WS_V), (bf16*)(F.ws + WS_ZA), (bf16*)(F.ws + WS_XL), (bf16*)(F.ws + WS_ZL), (bf16*)(F.ws + WS_GA), (bf16*)(F.ws + WS_GL), F.out, l};
#ifdef STAG_G
            { const int sg = ((int)blockIdx.x >> 3) & (STAG_G - 1);
              if (sg) { const long long t0 = wall_clock64(); while (wall_clock64() - t0 < (long long)sg * STAG_TICKS) __builtin_amdgcn_s_sleep(8); } }
#endif
            TP_BEGIN();
            pg8::gemm_phase<EpiIn, pg8::StaticOrder, true, true>(F.lds, g, S, E, F.tid);
            TP_END(101);
            ThinIn TE{E.Q, E.K, E.V, E.ZA, E.XL, E.ZL, E.GA, E.GL, F.out, l};
            TP_BEGIN2();
            thin_gemm<DM, DM, 3, ThinIn>(F, (const bf16*)(F.ws + WS_H) + (size_t)MP * DM, (const bf16*)(F.ws + WS_WIN) + (size_t)l * INC * DM, INC, TE);
            TP_END2(102);
        });
#endif
        SEAM(pb + 1);
#ifndef NO_PC
        if (IN(pb + 2)) REPEAT(4, { const Frame F = fresh(F0); phase_mix(F, l); });
#endif
        SEAM(pb + 2);
#ifndef NO_PC2
        if (IN(pb + 3)) REPEAT(5, { const Frame F = fresh(F0); phase_merge(F); });
#endif
        SEAM(pb + 3);
#ifndef NO_PD
        if (IN(pb + 4)) REPEAT(6, {
            const Frame F = fresh(F0);
            {
                TP_BEGIN2();
                ThinPAB TE{(const bf16*)(F.ws + WS_GA), (const bf16*)(F.ws + WS_GL), (bf16*)(F.ws + WS_MG)};
                thin_gemm_pair<ATTW, DM, DM, ThinPAB>(F, (const bf16*)(F.ws + WS_AA) + (size_t)MP * DM, (const bf16*)(F.ws + WS_WPA) + (size_t)l * DM * DM,
                                                      (const bf16*)(F.ws + WS_AL) + (size_t)MP * DM, (const bf16*)(F.ws + WS_WPB) + (size_t)l * DM * DM, DM, TE);
                TP_END2(103);
            }
            {
                pg8::Gemm g0{(const pg8::bf16_t*)(F.ws + WS_AA), (const pg8::bf16_t*)(F.ws + WS_WPA) + (size_t)l * DM * DM, MP, DM, ATTW};
                pg8::Gemm g1{(const pg8::bf16_t*)(F.ws + WS_AL), (const pg8::bf16_t*)(F.ws + WS_WPB) + (size_t)l * DM * DM, MP, DM, DM};
                pg8::StaticOrder S; S.init(MP, DM, F.G, (int)blockIdx.x);
                EpiMerge E{(const bf16*)(F.ws + WS_GA), (const bf16*)(F.ws + WS_GL), (bf16*)(F.ws + WS_MG)};
                pg8::gemm_chain<EpiMerge, pg8::StaticOrder>(F.lds, g0, g1, DM, S, E, F.tid);
            }
        });
#endif
        SEAM(pb + 4);
#ifndef NO_PE
        if (IN(pb + 5)) {
            const Frame F = fresh(F0);
            pg8::Gemm g{(const pg8::bf16_t*)(F.ws + WS_MG), (const pg8::bf16_t*)(F.ws + WS_WOUT) + (size_t)l * DM * DM, MP, DM, DM};
            pg8::StaticOrder S; S.init(MP, DM, F.G, (int)blockIdx.x);
            const KArgs A = kargs();
            EpiOut E{KIN(A, XP), KIN(A, XS), (float*)(F.ws + WS_X), (const float*)(F.ws + WS_MOD), l};
            ThinOut TE{E.xs, E.X, E.mod, l};
            TP_BEGIN2();
            thin_gemm<DM, DM, 1, ThinOut>(F, (const bf16*)(F.ws + WS_MG) + (size_t)MP * DM, (const bf16*)(F.ws + WS_WOUT) + (size_t)l * DM * DM, DM, TE);
            TP_END2(103);
            pg8::gemm_phase<EpiOut, pg8::StaticOrder, false, true>(F.lds, g, S, E, F.tid);
        }
#endif
        SEAM(pb + 5);
    }
#ifndef NO_PF
    { int lo2 = lo, hi2 = hi; asm volatile("" : "+s"(lo2), "+s"(hi2));
      if (lo2 <= N_PHASES - 1 && N_PHASES - 1 < hi2) { const Frame F = fresh(F0); phase_final(F); } }
#endif
#ifdef TPROBE
    {
        __syncthreads();
#ifndef TPROBE_SEAM
#define TPROBE_SEAM (-1)
#endif
#ifndef TPROBE_C
#define TPROBE_C 0
#endif
        const unsigned raw = ((volatile LAS unsigned*)(F0.lds + LDSCTL_OFF))[99 + TPROBE];
        const unsigned sel = TPROBE == 0 ? 50000u : (TPROBE_C > 0 ? (raw < (unsigned)TPROBE_C ? (unsigned)TPROBE_C - raw : 0u) : raw) * TPROBE_MUL;
        const unsigned t0 = (unsigned)__builtin_amdgcn_s_memrealtime();
        while ((unsigned)__builtin_amdgcn_s_memrealtime() - t0 < sel) __builtin_amdgcn_s_sleep(16);
    }
#endif
#undef IN
#undef SEAM
}

extern "C" void kernel_launch(void* const* d_in, const int* in_sizes, int n_in, void* d_out, int out_size, void* d_ws, size_t ws_size, hipStream_t stream) {
    static int grid = 0;
    if (grid == 0) {
        if (n_in != 25 || (size_t)out_size != O_END || ws_size < WS_END) { fprintf(stderr, "kernel_launch: built for 25 inputs, %zu outputs, >= %zu bytes of workspace; got n_in %d, out %d, ws %zu; nothing launched\n", (size_t)O_END, (size_t)WS_END, n_in, out_size, ws_size); grid = -1; return; }
        int dev = 0, cus = 0, per_cu = 0;
        if (hipGetDevice(&dev) != hipSuccess || hipDeviceGetAttribute(&cus, hipDeviceAttributeMultiprocessorCount, dev) != hipSuccess) { fprintf(stderr, "kernel_launch: device query failed\n"); grid = -1; return; }
        if (hipFuncSetAttribute((const void*)fwd_kernel, hipFuncAttributeMaxDynamicSharedMemorySize, LDS_BYTES) != hipSuccess) { fprintf(stderr, "kernel_launch: hipFuncSetAttribute failed\n"); grid = -1; return; }
        if (hipOccupancyMaxActiveBlocksPerMultiprocessor(&per_cu, (const void*)fwd_kernel, 512, LDS_BYTES) != hipSuccess || per_cu < 1) fprintf(stderr, "kernel_launch: note: occupancy query reports %d workgroups per CU\n", per_cu);
        (void)hipGetLastError();
        grid = cus;
    }
    if (grid < 0) return;
    static_assert((size_t)(CW_BAR + XCD_BAR_WORDS) * 4 <= 64 * 1024 && CW_P0Q < CW_BAR, "control words of the one-launch build lie in the first 64 KiB");
    if (hipMemsetAsync((char*)d_ws + WS_CTL, 0, MK_PER_PHASE ? CTL_ZERO_BYTES : (size_t)64 * 1024, stream) != hipSuccess) { fprintf(stderr, "kernel_launch: hipMemsetAsync failed\n"); return; }
    Args a{};
    for (int i = 0; i < 25; ++i) a.in[i] = (const float*)d_in[i];
    a.out = (float*)d_out; a.ws = (unsigned char*)d_ws;
#if MK_PER_PHASE
    for (int p = 0; p < N_PHASES; ++p) { a.ph_lo = p; a.ph_hi = p + 1; a.li = p; a.pad = 0; hipLaunchKernelGGL(fwd_kernel, dim3(grid), dim3(512), LDS_BYTES, stream, a); }
#else
    a.ph_lo = 0; a.ph_hi = N_PHASES; a.li = 0; a.pad = 0;
    hipLaunchKernelGGL(fwd_kernel, dim3(grid), dim3(512), LDS_BYTES, stream, a);
#endif
    const hipError_t le = hipPeekAtLastError();
    if (le != hipSuccess) fprintf(stderr, "kernel_launch: launch failed: %s\n", hipGetErrorName(le));
}
```

```cpp
#include <hip/hip_runtime.h>
#include <cstdio>
#include <cstdint>
namespace pg8 {
#define PG8_LAS __attribute__((address_space(3)))
typedef unsigned short bf16_t;
typedef short bf16x8 __attribute__((ext_vector_type(8)));
typedef float f32x4 __attribute__((ext_vector_type(4)));
typedef unsigned u32x4 __attribute__((ext_vector_type(4)));
constexpr int BM = 256, BK = 64, HALF = 128, HTB = HALF * BK * 2  , STAGE_BYTES = 8 * HTB, NXCD = 8, WGM = 8;

__host__ __device__ __forceinline__ int lds_byte(int r, int c) { const int st = (r >> 4) * 2 + (c >> 5), rr = r & 15, cc = c & 31, ob = rr * 64 + cc * 2; return st * 1024 + (ob ^ (((ob >> 9) & 1) << 5)); }
__host__ __device__ __forceinline__ void stage_rc(int b, int& R, int& C) { const int st = b / 1024, sb = b % 1024, swz = sb ^ (((sb >> 9) & 1) << 5); R = (st >> 1) * 16 + swz / 64; C = (st & 1) * 32 + (swz % 64) / 2; }
__host__ __device__ __forceinline__ int perm32(int rho) { const int n = rho >> 4, i = rho & 15; return 8 * (i >> 2) + 4 * n + (i & 3); }

struct Unit { int pm, pn; };
struct Gemm { const bf16_t* A; const bf16_t* Bt; int M, N, K; };

struct StaticOrder {
    int nM, nN, nwg, G, c;
    __host__ __device__ void init(int M, int N, int G_, int c_) { nM = M / BM; nN = N / BM; nwg = nM * nN; G = G_; c = c_; }
    __host__ __device__ bool next(int i, Unit& u) const {
        const long L = (long)i * G + c; if (L >= nwg) return false;
        int wgid = (int)L; { const int q = nwg / NXCD, r = nwg % NXCD, xcd = wgid % NXCD, off = wgid / NXCD; wgid = (xcd < r ? xcd * (q + 1) : r * (q + 1) + (xcd - r) * q) + off; }
        const int nig = WGM * nN, gid = wgid / nig, fm = gid * WGM, gsz = (nM - fm) < WGM ? (nM - fm) : WGM;
        u.pm = fm + ((wgid % nig) % gsz); u.pn = (wgid % nig) / gsz; return true;
    }
    __device__ __forceinline__ void a_ready(const Unit&) const {}
    __device__ __forceinline__ void done(const Unit&) const {}
};

__device__ __forceinline__ unsigned cvt_pk_bf16(float lo, float hi) { unsigned r; asm volatile("v_cvt_pk_bf16_f32 %0, %1, %2" : "=v"(r) : "v"(lo), "v"(hi)); return r; }
typedef float f32x2 __attribute__((ext_vector_type(2)));
template <class Epi, class Sched, bool ALIGN_EPI = false, bool SP2 = false>
__device__ __forceinline__ void gemm_phase(PG8_LAS unsigned char* lds, const Gemm g, const Sched& S, const Epi& E, int tid_in) {
    int tid_ = tid_in; asm volatile("" : "+v"(tid_));
    const int tid = tid_, wid = __builtin_amdgcn_readfirstlane(tid >> 6), lane = tid & 63, wr = wid >> 2, wc = wid & 3, fr = lane & 15, fq = lane >> 4;
    const int K = g.K, nt = K / BK;
    unsigned voffA[2], voffB[2];
#pragma unroll
    for (int i = 0; i < 2; ++i) { int R, C; stage_rc(tid * 16 + i * 8192, R, C); const int Rb = Epi::PERM ? ((R & ~31) + perm32(R & 31)) : R;
        voffA[i] = (unsigned)(R * K + C) * 2u; voffB[i] = (unsigned)(Rb * K + C) * 2u; }
    const size_t kstep = (size_t)(BK * 2);
    const size_t hstep = (size_t)HALF * K * 2;
    const size_t tstep = 2 * hstep;
    const unsigned ldsw = (unsigned)wid * 1024u;
    const int aoff = lds_byte(wr * 64 + fr, fq * 8), boff = lds_byte(wc * 32 + fr, fq * 8);
#define PG8_SA(b, h) (((b) * 2 + (h)) * HTB)
#define PG8_SB(b, h) ((4 + (b) * 2 + (h)) * HTB)
#define PG8_STAGE(bufoff, gbase, voff) do { _Pragma("unroll") for (int _i = 0; _i < 2; ++_i) \
        __builtin_amdgcn_global_load_lds((const unsigned*)((const char*)(gbase) + (voff)[_i]), (PG8_LAS unsigned*)(lds + (bufoff) + ldsw + _i * 8192), 16, 0, 0); } while (0)
#define PG8_LDA(dst, b, h) do { _Pragma("unroll") for (int m = 0; m < 4; ++m) _Pragma("unroll") for (int k = 0; k < 2; ++k) dst[m][k] = *(const PG8_LAS bf16x8*)(lds + PG8_SA(b, h) + aoff + m * 2048 + k * 1024); } while (0)
#define PG8_LDB(dst, b, h) do { _Pragma("unroll") for (int n = 0; n < 2; ++n) _Pragma("unroll") for (int k = 0; k < 2; ++k) dst[n][k] = *(const PG8_LAS bf16x8*)(lds + PG8_SB(b, h) + boff + n * 2048 + k * 1024); } while (0)
#define PG8_MMA(ai, bj, At, Bt) do { __builtin_amdgcn_s_setprio(1); _Pragma("unroll") for (int m = 0; m < 4; ++m) _Pragma("unroll") for (int n = 0; n < 2; ++n) _Pragma("unroll") for (int k = 0; k < 2; ++k) \
        acc[ai][bj][m][n] = __builtin_amdgcn_mfma_f32_16x16x32_bf16(Bt[n][k], At[m][k], acc[ai][bj][m][n], 0, 0, 0); __builtin_amdgcn_s_setprio(0); } while (0)
#define PG8_WAIT_V(n) asm volatile("s_waitcnt vmcnt(" #n ")" ::: "memory")
#define PG8_WAIT_VSEL(n, steady_) asm volatile("s_waitcnt vmcnt(%0)\n\ts_cmp_eq_u32 %1, 0\n\ts_cbranch_scc1 .Lpg8w%=\n\ts_waitcnt vmcnt(8)\n.Lpg8w%=:" :: "n"(n), "s"(steady_) : "memory", "scc")
#define PG8_WAIT_L(n) asm volatile("s_waitcnt lgkmcnt(" #n ")" ::: "memory")
#define PG8_BAR __builtin_amdgcn_s_barrier()
#define PG8_SCHED __builtin_amdgcn_sched_barrier(0)
    Unit cur, nxt; int ui = 0;
    if (!S.next(0, cur)) return;
    __builtin_amdgcn_s_waitcnt(0x0F70);
    f32x4 acc[2][2][4][2];
#pragma unroll
    for (int a = 0; a < 2; ++a)
#pragma unroll
        for (int b = 0; b < 2; ++b)
#pragma unroll
            for (int m = 0; m < 4; ++m)
#pragma unroll
                for (int n = 0; n < 2; ++n) acc[a][b][m][n] = (f32x4){0.f, 0.f, 0.f, 0.f};
    bf16x8 At[4][2], B0[2][2], B1[2][2];
    const char* cA = (const char*)g.A + (size_t)cur.pm * tstep; const char* cB = (const char*)g.Bt + (size_t)cur.pn * tstep;
    S.a_ready(cur);
    if constexpr (SP2) {
        PG8_STAGE(PG8_SB(0, 0), cB, voffB); PG8_STAGE(PG8_SB(0, 1), cB + hstep, voffB); PG8_STAGE(PG8_SA(0, 0), cA, voffA); PG8_STAGE(PG8_SA(0, 1), cA + hstep, voffA);
        if (wr == 1) PG8_BAR;
        PG8_WAIT_V(2); PG8_BAR;
        PG8_STAGE(PG8_SB(1, 0), cB + kstep, voffB); PG8_STAGE(PG8_SA(1, 0), cA + kstep, voffA); PG8_STAGE(PG8_SB(1, 1), cB + hstep + kstep, voffB);
        PG8_WAIT_V(6); PG8_BAR;
    } else {
        PG8_STAGE(PG8_SB(0, 0), cB, voffB); PG8_STAGE(PG8_SA(0, 0), cA, voffA); PG8_STAGE(PG8_SB(0, 1), cB + hstep, voffB); PG8_STAGE(PG8_SA(0, 1), cA + hstep, voffA);
        if (wr == 1) PG8_BAR;
        PG8_WAIT_V(4); PG8_BAR;
        PG8_STAGE(PG8_SB(1, 0), cB + kstep, voffB); PG8_STAGE(PG8_SA(1, 0), cA + kstep, voffA); PG8_STAGE(PG8_SB(1, 1), cB + hstep + kstep, voffB);
        PG8_WAIT_V(6); PG8_BAR;
    }
    for (;;) {
        const bool has_next = S.next(ui + 1, nxt);
        const char* nA = has_next ? (const char*)g.A + (size_t)nxt.pm * tstep : cA; const char* nB = has_next ? (const char*)g.Bt + (size_t)nxt.pn * tstep : cB;
        for (int t = 0; t < nt; t += 2) {
            const bool last = (t == nt - 2);
            const char* a1 = cA + (size_t)(t + 1) * kstep;
            const char* a2 = last ? nA : cA + (size_t)(t + 2) * kstep; const char* b2 = last ? nB : cB + (size_t)(t + 2) * kstep;
            const char* a3 = a2 + kstep; const char* b3 = b2 + kstep;
            if (last && has_next) S.a_ready(nxt);
            if constexpr (SP2) {
            const int steady = __builtin_amdgcn_readfirstlane((Epi::MIN_STORES > 0 && t == 0 && ui > 0) ? 0 : 1);
            PG8_LDB(B0, 0, 0); PG8_LDB(B1, 0, 1); PG8_SCHED; PG8_LDA(At, 0, 0); PG8_STAGE(PG8_SA(1, 1), a1 + hstep, voffA);
            if constexpr (Epi::MIN_STORES > 0) PG8_WAIT_VSEL(8 + Epi::MIN_STORES, steady); else PG8_WAIT_V(8);
            PG8_WAIT_L(0); PG8_BAR; PG8_MMA(0, 0, At, B0); PG8_MMA(0, 1, At, B1); PG8_BAR; PG8_SCHED;
            PG8_LDA(At, 0, 1); PG8_STAGE(PG8_SB(0, 0), b2, voffB); PG8_STAGE(PG8_SB(0, 1), b2 + hstep, voffB); PG8_STAGE(PG8_SA(0, 0), a2, voffA);
            if constexpr (Epi::MIN_STORES > 0) PG8_WAIT_VSEL(8 + Epi::MIN_STORES, steady); else PG8_WAIT_V(8);
            PG8_WAIT_L(0); PG8_BAR; PG8_MMA(1, 0, At, B0); PG8_MMA(1, 1, At, B1); PG8_BAR; PG8_SCHED;
            PG8_LDB(B0, 1, 0); PG8_LDB(B1, 1, 1); PG8_SCHED; PG8_LDA(At, 1, 0); PG8_STAGE(PG8_SA(0, 1), a2 + hstep, voffA);
            PG8_WAIT_V(8); PG8_WAIT_L(0); PG8_BAR; PG8_MMA(0, 0, At, B0); PG8_MMA(0, 1, At, B1); PG8_BAR; PG8_SCHED;
            PG8_LDA(At, 1, 1); PG8_STAGE(PG8_SB(1, 0), b3, voffB); PG8_STAGE(PG8_SB(1, 1), b3 + hstep, voffB); PG8_STAGE(PG8_SA(1, 0), a3, voffA);
            PG8_WAIT_V(8); PG8_WAIT_L(0); PG8_BAR; PG8_MMA(1, 0, At, B0); PG8_MMA(1, 1, At, B1); PG8_BAR; PG8_SCHED;
            } else {
            PG8_LDB(B0, 0, 0); PG8_SCHED; PG8_LDA(At, 0, 0); PG8_STAGE(PG8_SA(1, 1), a1 + hstep, voffA);
            PG8_WAIT_L(8); PG8_BAR; PG8_WAIT_L(0); PG8_MMA(0, 0, At, B0); PG8_BAR; PG8_SCHED;
            PG8_LDB(B1, 0, 1); PG8_STAGE(PG8_SB(0, 0), b2, voffB);
            PG8_BAR; PG8_WAIT_L(0); PG8_MMA(0, 1, At, B1); PG8_BAR;
            PG8_LDA(At, 0, 1); PG8_STAGE(PG8_SA(0, 0), a2, voffA);
            PG8_BAR; PG8_WAIT_L(0); PG8_MMA(1, 0, At, B0); PG8_BAR; PG8_SCHED;
            PG8_STAGE(PG8_SB(0, 1), b2 + hstep, voffB);
            PG8_WAIT_V(6); PG8_BAR; PG8_MMA(1, 1, At, B1); PG8_BAR;
            PG8_LDB(B0, 1, 0); PG8_SCHED; PG8_LDA(At, 1, 0); PG8_STAGE(PG8_SA(0, 1), a2 + hstep, voffA);
            PG8_WAIT_L(8); PG8_BAR; PG8_WAIT_L(0); PG8_MMA(0, 0, At, B0); PG8_BAR; PG8_SCHED;
            PG8_LDB(B1, 1, 1); PG8_STAGE(PG8_SB(1, 0), b3, voffB);
            PG8_BAR; PG8_WAIT_L(0); PG8_MMA(0, 1, At, B1); PG8_BAR;
            PG8_LDA(At, 1, 1); PG8_STAGE(PG8_SA(1, 0), a3, voffA);
            PG8_BAR; PG8_WAIT_L(0); PG8_MMA(1, 0, At, B0); PG8_BAR; PG8_SCHED;
            PG8_STAGE(PG8_SB(1, 1), b3 + hstep, voffB);
            PG8_WAIT_V(6); PG8_BAR; PG8_MMA(1, 1, At, B1); PG8_BAR;
            }
        }
        if constexpr (ALIGN_EPI) { if (wr == 0) PG8_BAR; }
#ifdef TPROBE
#ifndef TPROBE_ALLEPI
#define TPROBE_ALLEPI 0
#endif
        if constexpr (Epi::MIN_STORES > 0 || TPROBE_ALLEPI) {
            const unsigned tp0 = (unsigned)__builtin_amdgcn_s_memrealtime();
            E(acc, cur, wr, wc, fr, fq);
            asm volatile("" ::: "memory");
            const unsigned tp1 = (unsigned)__builtin_amdgcn_s_memrealtime();
            if (tid == 0) __hip_atomic_fetch_add((PG8_LAS unsigned*)(lds + STAGE_BYTES) + 100, tp1 - tp0, __ATOMIC_RELAXED, __HIP_MEMORY_SCOPE_WORKGROUP);
        } else
#endif
        if constexpr (!Epi::AFTER_DRAIN) { E(acc, cur, wr, wc, fr, fq); S.done(cur); }
        if (!has_next) break;
#pragma unroll
        for (int a = 0; a < 2; ++a)
#pragma unroll
            for (int b = 0; b < 2; ++b)
#pragma unroll
                for (int m = 0; m < 4; ++m)
#pragma unroll
                    for (int n = 0; n < 2; ++n) acc[a][b][m][n] = (f32x4){0.f, 0.f, 0.f, 0.f};
        cur = nxt; cA = nA; cB = nB; ++ui;
        if constexpr (ALIGN_EPI) { if (wr == 1) PG8_BAR; }
    }
    PG8_WAIT_V(0);
    if constexpr (!ALIGN_EPI) { if (wr == 0) PG8_BAR; }
    PG8_BAR;
    if constexpr (Epi::AFTER_DRAIN) { E.fused(acc, cur, wr, wc, fr, fq, lds, wid, lane); S.done(cur); }
#undef PG8_SA
#undef PG8_SB
#undef PG8_STAGE
#undef PG8_LDA
#undef PG8_LDB
#undef PG8_MMA
#undef PG8_WAIT_V
#undef PG8_WAIT_VSEL
#undef PG8_WAIT_L
#undef PG8_BAR
#undef PG8_SCHED
}
template <class Epi, class Sched>
__device__ __forceinline__ void gemm_chain(PG8_LAS unsigned char* lds, const Gemm g0, const Gemm g1, int ld, const Sched& S, const Epi& E, int tid_in) {
    int tid_ = tid_in; asm volatile("" : "+v"(tid_));
    const int tid = tid_, wid = __builtin_amdgcn_readfirstlane(tid >> 6), lane = tid & 63, wr = wid >> 2, wc = wid & 3, fr = lane & 15, fq = lane >> 4;
    const int K0 = g0.K, K1 = g1.K;
    unsigned voffA[2], voffB[2];
#pragma unroll
    for (int i = 0; i < 2; ++i) { int R, C; stage_rc(tid * 16 + i * 8192, R, C); const int Rb = Epi::PERM ? ((R & ~31) + perm32(R & 31)) : R;
        voffA[i] = (unsigned)(R * ld + C) * 2u; voffB[i] = (unsigned)(Rb * ld + C) * 2u; }
    const size_t kstep = (size_t)(BK * 2);
    const size_t hstep = (size_t)HALF * ld * 2, tstep = 2 * hstep;
    const unsigned ldsw = (unsigned)wid * 1024u;
    const int aoff = lds_byte(wr * 64 + fr, fq * 8), boff = lds_byte(wc * 32 + fr, fq * 8);
#define PG8_SA(b, h) (((b) * 2 + (h)) * HTB)
#define PG8_SB(b, h) ((4 + (b) * 2 + (h)) * HTB)
#define PG8_STAGE(bufoff, gbase, voff) do { _Pragma("unroll") for (int _i = 0; _i < 2; ++_i) \
        __builtin_amdgcn_global_load_lds((const unsigned*)((const char*)(gbase) + (voff)[_i]), (PG8_LAS unsigned*)(lds + (bufoff) + ldsw + _i * 8192), 16, 0, 0); } while (0)
#define PG8_LDA(dst, b, h) do { _Pragma("unroll") for (int m = 0; m < 4; ++m) _Pragma("unroll") for (int k = 0; k < 2; ++k) dst[m][k] = *(const PG8_LAS bf16x8*)(lds + PG8_SA(b, h) + aoff + m * 2048 + k * 1024); } while (0)
#define PG8_LDB(dst, b, h) do { _Pragma("unroll") for (int n = 0; n < 2; ++n) _Pragma("unroll") for (int k = 0; k < 2; ++k) dst[n][k] = *(const PG8_LAS bf16x8*)(lds + PG8_SB(b, h) + boff + n * 2048 + k * 1024); } while (0)
#define PG8_MMA(ai, bj, At, Bt) do { __builtin_amdgcn_s_setprio(1); _Pragma("unroll") for (int m = 0; m < 4; ++m) _Pragma("unroll") for (int n = 0; n < 2; ++n) _Pragma("unroll") for (int k = 0; k < 2; ++k) \
        acc[ai][bj][m][n] = __builtin_amdgcn_mfma_f32_16x16x32_bf16(Bt[n][k], At[m][k], acc[ai][bj][m][n], 0, 0, 0); __builtin_amdgcn_s_setprio(0); } while (0)
#define PG8_WAIT_V(n) asm volatile("s_waitcnt vmcnt(" #n ")" ::: "memory")
#define PG8_WAIT_L(n) asm volatile("s_waitcnt lgkmcnt(" #n ")" ::: "memory")
#define PG8_BAR __builtin_amdgcn_s_barrier()
#define PG8_SCHED __builtin_amdgcn_sched_barrier(0)
    Unit cur, nxt; int ui = 0;
    if (!S.next(0, cur)) return;
    f32x4 acc[2][2][4][2];
#pragma unroll
    for (int a = 0; a < 2; ++a)
#pragma unroll
        for (int b = 0; b < 2; ++b)
#pragma unroll
            for (int m = 0; m < 4; ++m)
#pragma unroll
                for (int n = 0; n < 2; ++n) acc[a][b][m][n] = (f32x4){0.f, 0.f, 0.f, 0.f};
    bf16x8 At[4][2], B0[2][2], B1[2][2];
    const char* cA = (const char*)g0.A + (size_t)cur.pm * tstep; const char* cB = (const char*)g0.Bt + (size_t)cur.pn * tstep;
    PG8_STAGE(PG8_SB(0, 0), cB, voffB); PG8_STAGE(PG8_SB(0, 1), cB + hstep, voffB); PG8_STAGE(PG8_SA(0, 0), cA, voffA); PG8_STAGE(PG8_SA(0, 1), cA + hstep, voffA);
    if (wr == 1) PG8_BAR;
    PG8_WAIT_V(2); PG8_BAR;
    PG8_STAGE(PG8_SB(1, 0), cB + kstep, voffB); PG8_STAGE(PG8_SA(1, 0), cA + kstep, voffA); PG8_STAGE(PG8_SB(1, 1), cB + hstep + kstep, voffB);
    PG8_WAIT_V(6); PG8_BAR;
#define PG8_KSTREAM(NT_, CA_, CB_, NA_, NB_) do { const int nt_ = (NT_); \
        for (int t = 0; t < nt_; t += 2) { \
            const bool last = (t == nt_ - 2); \
            const char* a1 = (CA_) + (size_t)(t + 1) * kstep; \
            const char* a2 = last ? (NA_) : (CA_) + (size_t)(t + 2) * kstep; const char* b2 = last ? (NB_) : (CB_) + (size_t)(t + 2) * kstep; \
            const char* a3 = a2 + kstep; const char* b3 = b2 + kstep; \
            PG8_LDB(B0, 0, 0); PG8_LDB(B1, 0, 1); PG8_SCHED; PG8_LDA(At, 0, 0); PG8_STAGE(PG8_SA(1, 1), a1 + hstep, voffA); \
            PG8_WAIT_V(8); PG8_WAIT_L(0); PG8_BAR; PG8_MMA(0, 0, At, B0); PG8_MMA(0, 1, At, B1); PG8_BAR; PG8_SCHED; \
            PG8_LDA(At, 0, 1); PG8_STAGE(PG8_SB(0, 0), b2, voffB); PG8_STAGE(PG8_SB(0, 1), b2 + hstep, voffB); PG8_STAGE(PG8_SA(0, 0), a2, voffA); \
            PG8_WAIT_V(8); PG8_WAIT_L(0); PG8_BAR; PG8_MMA(1, 0, At, B0); PG8_MMA(1, 1, At, B1); PG8_BAR; PG8_SCHED; \
            PG8_LDB(B0, 1, 0); PG8_LDB(B1, 1, 1); PG8_SCHED; PG8_LDA(At, 1, 0); PG8_STAGE(PG8_SA(0, 1), a2 + hstep, voffA); \
            PG8_WAIT_V(8); PG8_WAIT_L(0); PG8_BAR; PG8_MMA(0, 0, At, B0); PG8_MMA(0, 1, At, B1); PG8_BAR; PG8_SCHED; \
            PG8_LDA(At, 1, 1); PG8_STAGE(PG8_SB(1, 0), b3, voffB); PG8_STAGE(PG8_SB(1, 1), b3 + hstep, voffB); PG8_STAGE(PG8_SA(1, 0), a3, voffA); \
            PG8_WAIT_V(8); PG8_WAIT_L(0); PG8_BAR; PG8_MMA(1, 0, At, B0); PG8_MMA(1, 1, At, B1); PG8_BAR; PG8_SCHED; \
        } } while (0)
    for (;;) {
        const char* mA = (const char*)g1.A + (size_t)cur.pm * tstep; const char* mB = (const char*)g1.Bt + (size_t)cur.pn * tstep;
        PG8_KSTREAM(K0 / BK, cA, cB, mA, mB);
        E.mid(acc, cur, wr, wc, fr, fq);
        const bool has_tile = S.next(ui + 1, nxt);
        const char* nA = has_tile ? (const char*)g0.A + (size_t)nxt.pm * tstep : mA; const char* nB = has_tile ? (const char*)g0.Bt + (size_t)nxt.pn * tstep : mB;
        PG8_KSTREAM(K1 / BK, mA, mB, nA, nB);
        E(acc, cur, wr, wc, fr, fq);
        if (!has_tile) break;
#pragma unroll
        for (int a = 0; a < 2; ++a)
#pragma unroll
            for (int b = 0; b < 2; ++b)
#pragma unroll
                for (int m = 0; m < 4; ++m)
#pragma unroll
                    for (int n = 0; n < 2; ++n) acc[a][b][m][n] = (f32x4){0.f, 0.f, 0.f, 0.f};
        cur = nxt; cA = nA; cB = nB; ++ui;
    }
#undef PG8_KSTREAM
    PG8_WAIT_V(0);
    if (wr == 0) PG8_BAR;
    PG8_BAR;
#undef PG8_SA
#undef PG8_SB
#undef PG8_STAGE
#undef PG8_LDA
#undef PG8_LDB
#undef PG8_MMA
#undef PG8_WAIT_V
#undef PG8_WAIT_L
#undef PG8_BAR
#undef PG8_SCHED
}
}

#define GAS __attribute__((address_space(1)))
#define LAS __attribute__((address_space(3)))
typedef unsigned short bf16;
typedef unsigned u32x4 __attribute__((ext_vector_type(4)));
typedef unsigned u32x2 __attribute__((ext_vector_type(2)));
typedef float f32x4 __attribute__((ext_vector_type(4)));
typedef short bf16x8 __attribute__((ext_vector_type(8)));
typedef short s16x4 __attribute__((ext_vector_type(4)));

constexpr int DM = 2048, NB_P = 4, TT = 2048, DEPTH = 4, NB_S = 8, TS = 4;
constexpr int MP = NB_P * TT;
constexpr int MS = NB_S * TS;
constexpr int MR = MP + MS;
constexpr int MPAD = 8448;
constexpr int QKVW = 3072, ATTW = 1024, INC = 18432;
constexpr int C_K = 3072, C_V = 6144, C_ZA = 9216, C_XL = 10240, C_ZL = 12288, C_GA = 14336, C_GL = 16384;
constexpr int NMODB = 12;
constexpr float RMS_EPS = 1e-6f;
constexpr float LOG2E = 1.4426950408889634f;
constexpr float QSCALE = 0.08838834764831845f * 1.4426950408889634f;

constexpr size_t KVROW = 2048;
constexpr size_t O_YP = 0;
constexpr size_t O_YS = O_YP + (size_t)MP * DM;
constexpr size_t O_KVP0 = O_YS + (size_t)MS * DM;
constexpr size_t O_KVP1 = O_KVP0 + (size_t)DEPTH * NB_P * 128 * KVROW;
constexpr size_t O_KVP2 = O_KVP1 + (size_t)DEPTH * NB_P * 512 * KVROW;
constexpr size_t O_CVP = O_KVP2 + (size_t)DEPTH * NB_P * 2048 * KVROW;
constexpr size_t O_HP = O_CVP + (size_t)DEPTH * NB_P * 3 * DM;
constexpr size_t O_KVS0 = O_HP + (size_t)DEPTH * NB_P * DM;
constexpr size_t O_KVS1 = O_KVS0 + (size_t)DEPTH * NB_S * 128 * KVROW;
constexpr size_t O_KVS2 = O_KVS1 + (size_t)DEPTH * NB_S * 512 * KVROW;
constexpr size_t O_CVS = O_KVS2 + (size_t)DEPTH * NB_S * 2048 * KVROW;
constexpr size_t O_HS = O_CVS + (size_t)DEPTH * NB_S * 3 * DM;
constexpr size_t O_END = O_HS + (size_t)DEPTH * NB_S * DM;
static_assert(O_END == 281477120ull, "d_out size");

constexpr size_t MiB = 1u << 20;
constexpr size_t al1(size_t x) { return (x + MiB - 1) / MiB * MiB; }
constexpr size_t WS_CTL = 0, CTL_ZERO_BYTES = 1 * MiB;
constexpr size_t WS_WIN = 1 * MiB;
constexpr size_t WS_WPA = WS_WIN + al1((size_t)DEPTH * INC * DM * 2);
constexpr size_t WS_WPB = WS_WPA + al1((size_t)DEPTH * DM * DM * 2);
constexpr size_t WS_WOUT = WS_WPB + al1((size_t)DEPTH * DM * DM * 2);
constexpr size_t WS_WR = WS_WOUT + al1((size_t)DEPTH * DM * DM * 2);
constexpr size_t WS_WI = WS_WR + al1((size_t)DEPTH * 16 * 128 * 128 * 2);
constexpr size_t WS_MODP = WS_WI + al1((size_t)DEPTH * 16 * 128 * 128 * 2);
constexpr size_t WS_MOD = WS_MODP + al1((size_t)DEPTH * 16 * NMODB * 6144 * 4);
constexpr size_t WS_H = WS_MOD + al1((size_t)DEPTH * NMODB * 6144 * 4);
constexpr size_t WS_Q = WS_H + al1((size_t)MPAD * DM * 2);
constexpr size_t WS_K = WS_Q + al1((size_t)MPAD * QKVW * 2);
constexpr size_t WS_V = WS_K + al1((size_t)MPAD * QKVW * 2);
constexpr size_t WS_ZA = WS_V + al1((size_t)MPAD * QKVW * 2);
constexpr size_t WS_XL = WS_ZA + al1((size_t)MPAD * ATTW * 2);
constexpr size_t WS_ZL = WS_XL + al1((size_t)MPAD * DM * 2);
constexpr size_t WS_GA = WS_ZL + al1((size_t)MPAD * DM * 2);
constexpr size_t WS_GL = WS_GA + al1((size_t)MPAD * DM * 2);
constexpr size_t WS_OG = WS_GL + al1((size_t)MPAD * DM * 2);
constexpr size_t WS_LSE = WS_OG + al1((size_t)3 * MPAD * ATTW * 2);
constexpr size_t WS_AA = WS_LSE + al1((size_t)3 * MPAD * 8 * 4);
constexpr size_t WS_AL = WS_AA + al1((size_t)MPAD * DM * 2);
constexpr size_t WS_TMP = WS_AL + al1((size_t)MPAD * DM * 2);
constexpr size_t WS_MG = WS_TMP + al1((size_t)MPAD * DM * 4);
constexpr size_t WS_X = WS_MG + al1((size_t)MPAD * DM * 2);
constexpr size_t WS_END = WS_X + al1((size_t)MPAD * DM * 4);
constexpr int CW_P0Q = 256;
constexpr int CW_BAR = 4096;

constexpr int RING_BYTES = 131072;
constexpr int LDSCTL_OFF = RING_BYTES;
constexpr int LDSBIAS_OFF = RING_BYTES + 512;
constexpr int LDS_BYTES = 147456;

#define LDS_WAIT() asm volatile("s_waitcnt lgkmcnt(0)" ::: "memory")
#define VM_WAIT() asm volatile("s_waitcnt vmcnt(0)" ::: "memory")

__device__ __forceinline__ unsigned pk2(float lo, float hi) { return pg8::cvt_pk_bf16(lo, hi); }
__device__ __forceinline__ float bflo(unsigned w) { return __uint_as_float(w << 16); }
__device__ __forceinline__ float bfhi(unsigned w) { return __uint_as_float(w & 0xffff0000u); }
__device__ __forceinline__ float bf1(bf16 v) { return __uint_as_float(((unsigned)v) << 16); }
__device__ __forceinline__ float sigm(float v) { return __builtin_amdgcn_rcpf(1.0f + __expf(-v)); }
__device__ __forceinline__ float shfl_x(float v, int m, int lane) { return __builtin_bit_cast(float, __builtin_amdgcn_ds_bpermute((lane ^ m) << 2, __builtin_bit_cast(int, v))); }
__device__ __forceinline__ float shfl_u(float v, int d, int lane) { const int src = lane - d; return __builtin_bit_cast(float, __builtin_amdgcn_ds_bpermute((src < 0 ? lane : src) << 2, __builtin_bit_cast(int, v))); }
__device__ __forceinline__ float wave_sum(float v, int lane) {
#pragma unroll
    for (int o = 1; o < 64; o <<= 1) v += shfl_x(v, o, lane);
    return v;
}
__device__ __forceinline__ float wave_max(float v, int lane) {
#pragma unroll
    for (int o = 1; o < 64; o <<= 1) v = fmaxf(v, shfl_x(v, o, lane));
    return v;
}
__device__ __forceinline__ int t5_bucket(int d) {
    if (d < 16) return d;
    int b = 16;
    b += (d >= 22); b += (d >= 30); b += (d >= 40); b += (d >= 54); b += (d >= 73); b += (d >= 99); b += (d >= 134); b += (d >= 182);
    b += (d >= 246); b += (d >= 332); b += (d >= 450); b += (d >= 609); b += (d >= 825); b += (d >= 1117); b += (d >= 1513);
    return b;
}

__device__ __forceinline__ int hw_lane() { int l; asm volatile("v_mbcnt_lo_u32_b32 %0, -1, 0\n\tv_mbcnt_hi_u32_b32 %0, -1, %0" : "=v"(l)); return l; }
struct Args { const float* in[25]; float* out; unsigned char* ws; int ph_lo, ph_hi, li, pad; };
enum InIdx { I_XP = 0, I_XS, I_CP, I_CS, I_C0, I_C1, I_C2, I_SCONV, I_SH, I_RELB, I_WADA, I_BADA, I_NORMG, I_WIN, I_CONVW, I_CONVB, I_WR, I_BR, I_WI, I_BI, I_LAM, I_WPA, I_WPB, I_WOUT, I_FING };

struct Frame {
    LAS unsigned char* lds;
    int tid, lane, wave, vcu, G;
    GAS float* out; GAS unsigned char* ws;
};
typedef const __attribute__((address_space(4))) Args* KArgs;
__device__ __forceinline__ KArgs kargs() { KArgs p = (KArgs)__builtin_amdgcn_kernarg_segment_ptr(); asm volatile("" : "+s"(p)); return p; }
#define KIN(A, NAME) ((const float*)(const GAS float*)(A)->in[I_##NAME])
__device__ __forceinline__ Frame fresh(const Frame& F0) {
    Frame F = F0; int lane = hw_lane();
    asm volatile("" : "+v"(lane), "+s"(F.ws), "+s"(F.out), "+s"(F.vcu), "+s"(F.wave), "+s"(F.G)); F.lane = lane; F.tid = F.wave * 64 + lane; return F; }


constexpr int KVC_S0 = (128 - 4) * 512, KVC_S1 = (512 - 4) * 512, KVC_S2 = (2048 - 4) * 512;
constexpr int KVC_C1 = DEPTH * NB_S * KVC_S0, KVC_C2 = KVC_C1 + DEPTH * NB_S * KVC_S1, KVC_TOTAL = KVC_C2 + DEPTH * NB_S * KVC_S2;
constexpr int KVC_RIDE = 4;
constexpr int KVC_LRIDE = 1;
constexpr int KVC_LQ = KVC_TOTAL / 4, KVC_LAYER = 2191872, KVC_ATT = 1536 * 512 * KVC_RIDE, KVC_LRU = 256 * 16 * 512 * KVC_LRIDE, KVC_REM = KVC_LQ - KVC_LAYER - KVC_ATT - KVC_LRU;
static_assert(KVC_TOTAL % 4 == 0 && KVC_REM >= 0, "copy partition");
static_assert(KVC_LAYER >= KVC_C1 && KVC_LAYER + KVC_ATT + KVC_LRU <= KVC_C2 && KVC_LQ + KVC_LAYER >= KVC_C2 && KVC_LAYER % 512 == 0, "riding ranges vs. group boundaries");
__device__ __forceinline__ void kvc_map(KArgs A, GAS float* out, int i, const f32x4*& sp, f32x4*& dp) {
    int j = i, W, S; const f32x4* sb; GAS f32x4* db;
    if (j < KVC_C1) { W = 128; S = KVC_S0; sb = (const f32x4*)KIN(A, C0); db = (GAS f32x4*)(out + O_KVS0); }
    else if (j < KVC_C2) { j -= KVC_C1; W = 512; S = KVC_S1; sb = (const f32x4*)KIN(A, C1); db = (GAS f32x4*)(out + O_KVS1); }
    else { j -= KVC_C2; W = 2048; S = KVC_S2; sb = (const f32x4*)KIN(A, C2); db = (GAS f32x4*)(out + O_KVS2); }
    const int sg = j / S, of = j - sg * S; const size_t o = (size_t)sg * W * 512 + of; sp = sb + o + 2048; dp = (f32x4*)(db + o);
}
__device__ __forceinline__ void kvc_map1(KArgs A, GAS float* out, int grp, int i, const f32x4*& sp, f32x4*& dp) {
    const int W = grp == 0 ? 128 : (grp == 1 ? 512 : 2048), S = grp == 0 ? KVC_S0 : (grp == 1 ? KVC_S1 : KVC_S2), j = i - (grp == 0 ? 0 : (grp == 1 ? KVC_C1 : KVC_C2));
    const f32x4* sb = (const f32x4*)(grp == 0 ? KIN(A, C0) : (grp == 1 ? KIN(A, C1) : KIN(A, C2)));
    GAS f32x4* db = (GAS f32x4*)(out + (grp == 0 ? O_KVS0 : (grp == 1 ? O_KVS1 : O_KVS2)));
    const int sg = j / S, of = j - sg * S; const size_t o = (size_t)sg * W * 512 + of; sp = sb + o + 2048; dp = (f32x4*)(db + o);
}
__device__ __forceinline__ void kvcopy_range(const Frame& F, int i0, int i1, int tix, int nth) {
    const KArgs A = kargs();
    int i = i0 + tix;
#pragma unroll 1
    for (; i + 15 * nth < i1; i += 16 * nth) {
        f32x4 v[16]; f32x4* dp[16];
#pragma unroll
        for (int j = 0; j < 16; ++j) { const f32x4* sp; kvc_map(A, F.out, i + j * nth, sp, dp[j]); v[j] = __builtin_nontemporal_load(sp); }
#pragma unroll
        for (int j = 0; j < 16; ++j) __builtin_nontemporal_store(v[j], dp[j]);
    }
#pragma unroll 1
    for (; i < i1; i += nth) { const f32x4* sp; f32x4* dp; kvc_map(A, F.out, i, sp, dp); __builtin_nontemporal_store(__builtin_nontemporal_load(sp), dp); }
}
struct BgCopy4 {
    f32x4 v[4]; f32x4* dp[4];
    __device__ __forceinline__ void request(GAS float* out, int start, int tid) {
        const KArgs A = kargs();
#pragma unroll
        for (int j = 0; j < 4; ++j) { const f32x4* sp; kvc_map(A, out, start + j * 512 + tid, sp, dp[j]); v[j] = __builtin_nontemporal_load(sp); }
        asm volatile("" ::: "memory");
    }
    __device__ __forceinline__ void finish() {
        asm volatile("" ::: "memory");
#pragma unroll
        for (int j = 0; j < 4; ++j) __builtin_nontemporal_store(v[j], dp[j]);
    }
};
#ifndef EPI_MINST
#define EPI_MINST 16
#endif
struct EpiIn {
    static constexpr bool PERM = true, AFTER_DRAIN = false; static constexpr int MIN_STORES = EPI_MINST;
    bf16 *Q, *K, *V, *ZA, *XL, *ZL, *GA, *GL; GAS float* out; int l;
    __device__ __forceinline__ void operator()(const pg8::f32x4 (&acc)[2][2][4][2], const pg8::Unit& u, int wr, int wc, int fr, int fq) const {
#ifdef PROBE_FIXPN
        int upm = u.pm, upn = u.pn;
        const int fix = this->l >> 8, l = this->l & 255;
        if (fix) { const int bx = blockIdx.x, v = (bx % 8) * 32 + bx / 8; upm = (v >> 2) & 31; upn = PROBE_FIXPN + (v >> 7); }
        const int row0 = upm * 256 + wr * 64 + fr, ct = upn * 256, cl = wc * 32 + 8 * fq;
#else
        const int row0 = u.pm * 256 + wr * 64 + fr, ct = u.pn * 256, cl = wc * 32 + 8 * fq;
#endif
        GAS float* out = this->out; asm volatile("" : "+s"(out));
        int mode, ld, cc; bf16* base;
        if (ct < C_K) { mode = 0; base = Q; ld = QKVW; cc = ct; }
        else if (ct < C_V) { mode = 1; base = K; ld = QKVW; cc = ct - C_K; }
        else if (ct < C_ZA) { mode = 2; base = V; ld = QKVW; cc = ct - C_V; }
        else if (ct < C_XL) { mode = 6; base = ZA; ld = ATTW; cc = ct - C_ZA; }
        else if (ct < C_ZL) { mode = 4; base = XL; ld = DM; cc = ct - C_XL; }
        else if (ct < C_GA) { mode = 3; base = ZL; ld = DM; cc = ct - C_ZL; }
        else if (ct < C_GL) { mode = 5; base = GA; ld = DM; cc = ct - C_GA; }
        else { mode = 5; base = GL; ld = DM; cc = ct - C_GL; }
        const int gi = cc >> 10;
        const int Wg = gi == 0 ? 128 : (gi == 1 ? 512 : 2048);
        GAS float* kvp = out + (gi == 0 ? O_KVP0 : (gi == 1 ? O_KVP1 : O_KVP2));
        GAS float* kvs = out + (gi == 0 ? O_KVS0 : (gi == 1 ? O_KVS1 : O_KVS2));
#pragma unroll
        for (int ai = 0; ai < 2; ++ai)
#pragma unroll
            for (int m = 0; m < 4; ++m) {
                const int r = row0 + ai * 128 + m * 16;
                bf16* rowp = base + (size_t)r * ld + cc + cl;
                GAS float* f32dst = nullptr;
                if (mode == 1 || mode == 2) {
                    if (r < MP) { const int b = r >> 11, t = r & 2047; if (t >= TT - Wg) f32dst = kvp + (((size_t)(l * NB_P + b) * Wg + (t - (TT - Wg))) * 2 + (mode - 1)) * 1024 + (cc & 1023); }
                    else if (r < MR) { const int bs = (r - MP) >> 2, s = (r - MP) & 3; f32dst = kvs + (((size_t)(l * NB_S + bs) * Wg + (Wg - 4 + s)) * 2 + (mode - 1)) * 1024 + (cc & 1023); }
                } else if (mode == 4) {
                    if (r < MP) { const int b = r >> 11, t = r & 2047; if (t >= TT - 3) f32dst = out + O_CVP + ((size_t)(l * NB_P + b) * 3 + (t - (TT - 3))) * DM + cc; }
                    else if (r < MR) { const int bs = (r - MP) >> 2, s = (r - MP) & 3; if (s >= 1) f32dst = out + O_CVS + ((size_t)(l * NB_S + bs) * 3 + (s - 1)) * DM + cc; }
                }
#pragma unroll
                for (int bj = 0; bj < 2; ++bj) {
                    pg8::f32x4 v0 = acc[ai][bj][m][0], v1 = acc[ai][bj][m][1];
                    if (f32dst) { __builtin_nontemporal_store(v0, (GAS pg8::f32x4*)(f32dst + cl + bj * 128)); __builtin_nontemporal_store(v1, (GAS pg8::f32x4*)(f32dst + cl + bj * 128 + 4)); }
                    if (mode == 0) { v0 = v0 * QSCALE; v1 = v1 * QSCALE; }
                    else if (mode == 3) {
#pragma unroll
                        for (int j = 0; j < 4; ++j) { v0[j] = v0[j] * sigm(v0[j]); v1[j] = v1[j] * sigm(v1[j]); }
                    } else if (mode == 5) {
#pragma unroll
                        for (int j = 0; j < 4; ++j) { v0[j] = sigm(v0[j]); v1[j] = sigm(v1[j]); }
                    }
                    u32x4 w; w.x = pk2(v0[0], v0[1]); w.y = pk2(v0[2], v0[3]); w.z = pk2(v1[0], v1[1]); w.w = pk2(v1[2], v1[3]);
#ifdef EPI_NT_BF16
                    __builtin_nontemporal_store(w, (u32x4*)(rowp + bj * 128));
#else
                    *(u32x4*)(rowp + bj * 128) = w;
#endif
                }
            }
    }
};
struct EpiPA {
    static constexpr bool PERM = true, AFTER_DRAIN = false; static constexpr int MIN_STORES = 0;
    const bf16* GA; bf16* TMP;
    __device__ __forceinline__ void operator()(const pg8::f32x4 (&acc)[2][2][4][2], const pg8::Unit& u, int wr, int wc, int fr, int fq) const {
        const int row0 = u.pm * 256 + wr * 64 + fr, col0 = u.pn * 256 + wc * 32 + 8 * fq;
#pragma unroll
        for (int ai = 0; ai < 2; ++ai)
#pragma unroll
            for (int m = 0; m < 4; ++m) {
                const size_t ro = (size_t)(row0 + ai * 128 + m * 16) * DM + col0;
#pragma unroll
                for (int bj = 0; bj < 2; ++bj) {
                    const u32x4 g = *(const u32x4*)(GA + ro + bj * 128);
                    pg8::f32x4 v0 = acc[ai][bj][m][0], v1 = acc[ai][bj][m][1];
                    v0[0] *= bflo(g.x); v0[1] *= bfhi(g.x); v0[2] *= bflo(g.y); v0[3] *= bfhi(g.y);
                    v1[0] *= bflo(g.z); v1[1] *= bfhi(g.z); v1[2] *= bflo(g.w); v1[3] *= bfhi(g.w);
                    u32x4 w; w.x = pk2(v0[0], v0[1]); w.y = pk2(v0[2], v0[3]); w.z = pk2(v1[0], v1[1]); w.w = pk2(v1[2], v1[3]);
                    *(u32x4*)(TMP + ro + bj * 128) = w;
                }
                asm volatile("" ::: "memory");
            }
    }
};
struct EpiPB {
    static constexpr bool PERM = true, AFTER_DRAIN = false; static constexpr int MIN_STORES = 0;
    const bf16* GL; const bf16* TMP; bf16* MG;
    __device__ __forceinline__ void operator()(const pg8::f32x4 (&acc)[2][2][4][2], const pg8::Unit& u, int wr, int wc, int fr, int fq) const {
        const int row0 = u.pm * 256 + wr * 64 + fr, col0 = u.pn * 256 + wc * 32 + 8 * fq;
#pragma unroll
        for (int ai = 0; ai < 2; ++ai)
#pragma unroll
            for (int m = 0; m < 4; ++m) {
                const size_t ro = (size_t)(row0 + ai * 128 + m * 16) * DM + col0;
#pragma unroll
                for (int bj = 0; bj < 2; ++bj) {
                    const u32x4 g = *(const u32x4*)(GL + ro + bj * 128);
                    const u32x4 tw = *(const u32x4*)(TMP + ro + bj * 128);
                    const pg8::f32x4 t0 = (pg8::f32x4){bflo(tw.x), bfhi(tw.x), bflo(tw.y), bfhi(tw.y)}, t1 = (pg8::f32x4){bflo(tw.z), bfhi(tw.z), bflo(tw.w), bfhi(tw.w)};
                    pg8::f32x4 v0 = acc[ai][bj][m][0], v1 = acc[ai][bj][m][1];
                    v0[0] = t0[0] + v0[0] * bflo(g.x); v0[1] = t0[1] + v0[1] * bfhi(g.x); v0[2] = t0[2] + v0[2] * bflo(g.y); v0[3] = t0[3] + v0[3] * bfhi(g.y);
                    v1[0] = t1[0] + v1[0] * bflo(g.z); v1[1] = t1[1] + v1[1] * bfhi(g.z); v1[2] = t1[2] + v1[2] * bflo(g.w); v1[3] = t1[3] + v1[3] * bfhi(g.w);
                    u32x4 w; w.x = pk2(v0[0], v0[1]); w.y = pk2(v0[2], v0[3]); w.z = pk2(v1[0], v1[1]); w.w = pk2(v1[2], v1[3]);
                    *(u32x4*)(MG + ro + bj * 128) = w;
                }
                asm volatile("" ::: "memory");
            }
    }
};
struct EpiMerge {
    static constexpr bool PERM = true, AFTER_DRAIN = false; static constexpr int MIN_STORES = 0;
    const bf16* GA; const bf16* GL; bf16* MG;
    static __device__ __forceinline__ float clampg(float g) { return fmaxf(g, 8.673617379884035e-19f); }
    __device__ __forceinline__ void mid(pg8::f32x4 (&acc)[2][2][4][2], const pg8::Unit& u, int wr, int wc, int fr, int fq) const {
        const GAS bf16* GA = (const GAS bf16*)this->GA; const GAS bf16* GL = (const GAS bf16*)this->GL; asm volatile("" : "+s"(GA), "+s"(GL), "+v"(fr), "+v"(fq));
        const int row0 = u.pm * 256 + wr * 64 + fr, col0 = u.pn * 256 + wc * 32 + 8 * fq;
#pragma unroll
        for (int ai = 0; ai < 2; ++ai)
#pragma unroll
            for (int mp = 0; mp < 4; mp += 2) {
                u32x4 a[2][2], g[2][2];
#pragma unroll
                for (int mm = 0; mm < 2; ++mm)
#pragma unroll
                    for (int bj = 0; bj < 2; ++bj) { const size_t ro = (size_t)(row0 + ai * 128 + (mp + mm) * 16) * DM + col0 + bj * 128; a[mm][bj] = *(const GAS u32x4*)(GA + ro); g[mm][bj] = *(const GAS u32x4*)(GL + ro); }
#pragma unroll
                for (int mm = 0; mm < 2; ++mm) {
#pragma unroll
                    for (int bj = 0; bj < 2; ++bj)
#pragma unroll
                        for (int e = 0; e < 4; ++e) {
                            acc[ai][bj][mp + mm][e >> 1][2 * (e & 1)] *= bflo(a[mm][bj][e]) * __builtin_amdgcn_rcpf(clampg(bflo(g[mm][bj][e])));
                            acc[ai][bj][mp + mm][e >> 1][2 * (e & 1) + 1] *= bfhi(a[mm][bj][e]) * __builtin_amdgcn_rcpf(clampg(bfhi(g[mm][bj][e])));
                        }
                    asm volatile("" : "+v"(acc[ai][0][mp + mm][0]), "+v"(acc[ai][0][mp + mm][1]), "+v"(acc[ai][1][mp + mm][0]), "+v"(acc[ai][1][mp + mm][1]) :: "memory");
                }
            }
    }
    __device__ __forceinline__ void operator()(const pg8::f32x4 (&acc)[2][2][4][2], const pg8::Unit& u, int wr, int wc, int fr, int fq) const {
        const GAS bf16* GL = (const GAS bf16*)this->GL; GAS bf16* MG = (GAS bf16*)this->MG; asm volatile("" : "+s"(GL), "+s"(MG), "+v"(fr), "+v"(fq));
        const int row0 = u.pm * 256 + wr * 64 + fr, col0 = u.pn * 256 + wc * 32 + 8 * fq;
#pragma unroll
        for (int ai = 0; ai < 2; ++ai)
#pragma unroll
            for (int mp = 0; mp < 4; mp += 2) {
                u32x4 g[2][2];
#pragma unroll
                for (int mm = 0; mm < 2; ++mm)
#pragma unroll
                    for (int bj = 0; bj < 2; ++bj) g[mm][bj] = *(const GAS u32x4*)(GL + (size_t)(row0 + ai * 128 + (mp + mm) * 16) * DM + col0 + bj * 128);
#pragma unroll
                for (int mm = 0; mm < 2; ++mm)
#pragma unroll
                    for (int bj = 0; bj < 2; ++bj) {
                        u32x4 w;
#pragma unroll
                        for (int e = 0; e < 4; ++e) w[e] = pk2(acc[ai][bj][mp + mm][e >> 1][2 * (e & 1)] * clampg(bflo(g[mm][bj][e])), acc[ai][bj][mp + mm][e >> 1][2 * (e & 1) + 1] * clampg(bfhi(g[mm][bj][e])));
                        *(GAS u32x4*)(MG + (size_t)(row0 + ai * 128 + (mp + mm) * 16) * DM + col0 + bj * 128) = w;
                    }
                asm volatile("" ::: "memory");
            }
    }
};
struct EpiOut {
    static constexpr bool PERM = false, AFTER_DRAIN = false; static constexpr int MIN_STORES = 0;
    const float* xp; const float* xs; float* X; const float* mod; int l;
    __device__ __forceinline__ void operator()(const pg8::f32x4 (&acc)[2][2][4][2], const pg8::Unit& u, int wr, int wc, int fr, int fq) const {
        const GAS float* xo = (const GAS float*)(l == 0 ? xp : X); GAS float* Xn = (GAS float*)X; const GAS float* gp = (const GAS float*)mod + ((size_t)(l * NMODB + (u.pm >> 3))) * 6144 + 4096;
        asm volatile("" : "+s"(xo), "+s"(Xn), "+s"(gp), "+v"(fr), "+v"(fq));
        const int row0 = u.pm * 256 + wr * 64 + fr, col0 = u.pn * 256 + wc * 32 + 4 * fq;
        pg8::f32x4 g4[2][2];
#pragma unroll
        for (int bj = 0; bj < 2; ++bj)
#pragma unroll
            for (int n = 0; n < 2; ++n) g4[bj][n] = *(const GAS pg8::f32x4*)(gp + col0 + bj * 128 + n * 16);
#pragma unroll
        for (int ai = 0; ai < 2; ++ai)
#pragma unroll
            for (int mp = 0; mp < 4; mp += 2) {
                pg8::f32x4 x4[2][2][2];
#pragma unroll
                for (int mm = 0; mm < 2; ++mm)
#pragma unroll
                    for (int bj = 0; bj < 2; ++bj)
#pragma unroll
                        for (int n = 0; n < 2; ++n) x4[mm][bj][n] = *(const GAS pg8::f32x4*)(xo + (size_t)(row0 + ai * 128 + (mp + mm) * 16) * DM + col0 + bj * 128 + n * 16);
#pragma unroll
                for (int mm = 0; mm < 2; ++mm)
#pragma unroll
                    for (int bj = 0; bj < 2; ++bj)
#pragma unroll
                        for (int n = 0; n < 2; ++n) *(GAS pg8::f32x4*)(Xn + (size_t)(row0 + ai * 128 + (mp + mm) * 16) * DM + col0 + bj * 128 + n * 16) = x4[mm][bj][n] + g4[bj][n] * acc[ai][bj][mp + mm][n];
                asm volatile("" ::: "memory");
            }
    }
};
template <bool P> struct EpiNull {
    static constexpr bool PERM = P, AFTER_DRAIN = false; static constexpr int MIN_STORES = 0;
    __device__ __forceinline__ void mid(pg8::f32x4 (&acc)[2][2][4][2], const pg8::Unit&, int, int, int, int) const {}
    __device__ __forceinline__ void operator()(const pg8::f32x4 (&acc)[2][2][4][2], const pg8::Unit&, int, int, int, int) const {
#pragma unroll
        for (int a = 0; a < 2; ++a)
#pragma unroll
            for (int b = 0; b < 2; ++b)
#pragma unroll
                for (int m = 0; m < 4; ++m)
#pragma unroll
                    for (int n = 0; n < 2; ++n) asm volatile("" :: "v"(acc[a][b][m][n]));
    }
};
#define XB_TMO      128
#define XB_XCNT(j)  (256  + 64 * (j))
#define XB_XSUB(j)  (1280 + 64 * (j))
#define XB_XGEN(j)  (2304 + 64 * (j))
#define XB_TOP      3328
#define XB_TOPGEN   3392
#define XCD_BAR_WORDS 3456
#define XB_SPIN_CAP (1u << 18)

__device__ __forceinline__ unsigned xb_ld(unsigned* p)              { return __hip_atomic_load(p, __ATOMIC_RELAXED, __HIP_MEMORY_SCOPE_AGENT); }
__device__ __forceinline__ unsigned xb_add(unsigned* p, unsigned v) { return __hip_atomic_fetch_add(p, v, __ATOMIC_RELAXED, __HIP_MEMORY_SCOPE_AGENT); }
__device__ __forceinline__ unsigned xb_xcc_id() { return (unsigned)__builtin_amdgcn_s_getreg((3 << 11) | 20) & 0xFu; }
#define XB_SPIN(cond, bar) do { unsigned _sp = 0; while (cond) { __builtin_amdgcn_s_sleep(1); \
    if ((++_sp & 255u) == 0u) { if (xb_ld(&(bar)[XB_TMO])) break; if (_sp > XB_SPIN_CAP) { atomicAdd(&(bar)[XB_TMO], 1u); break; } } } } while (0)

struct XcdBarrier {
    unsigned* bar; unsigned x;
    volatile LAS unsigned* st;
};

__device__ __forceinline__ XcdBarrier xcd_barrier_post(unsigned* bar, volatile LAS unsigned* st) {
    XcdBarrier b; b.bar = bar; b.x = xb_xcc_id(); b.st = st;
    if (threadIdx.x == 0) (void)xb_add(&bar[XB_XCNT(b.x)], 1u);
    return b;
}
__device__ __forceinline__ void xcd_barrier_complete(unsigned* bar, unsigned x, unsigned& nloc, unsigned& nx) {
    const unsigned G = gridDim.x * gridDim.y * gridDim.z;
    unsigned sum, cnt, mine, sp = 0u;
    for (;;) {
        sum = 0u; cnt = 0u; mine = 0u;
#pragma unroll
        for (unsigned j = 0; j < 16; ++j) { const unsigned c = xb_ld(&bar[XB_XCNT(j)]); sum += c; cnt += (c > 0u) ? 1u : 0u; mine = (j == x) ? c : mine; }
        if (sum == G) break;
        __builtin_amdgcn_s_sleep(1);
        if ((++sp & 255u) == 0u) { if (xb_ld(&bar[XB_TMO])) break; if (sp > XB_SPIN_CAP) { atomicAdd(&bar[XB_TMO], 1u); break; } }
    }
    nloc = mine > 0u ? mine : 1u; nx = cnt > 0u ? cnt : 1u;
}

__device__ __forceinline__ void xcd_barrier(const XcdBarrier& b, bool is_t0  ) {
    asm volatile("s_waitcnt vmcnt(0)" ::: "memory");
    __syncthreads();
    if (is_t0) {
        unsigned* bar = b.bar;
        __builtin_amdgcn_s_waitcnt(0);
        unsigned nloc = b.st[0], nx = b.st[1];
        if (nloc == 0u) { xcd_barrier_complete(bar, b.x, nloc, nx); b.st[0] = nloc; b.st[1] = nx; }
        const unsigned old = xb_add(&bar[XB_XSUB(b.x)], 1u);
        const unsigned gen = old / nloc;
        if (old + 1u == (gen + 1u) * nloc) {
            __builtin_amdgcn_fence(__ATOMIC_RELEASE, "agent");
            asm volatile("s_waitcnt vmcnt(0)" ::: "memory");
            const unsigned og = xb_add(&bar[XB_TOP], 1u);
            const unsigned tg = og / nx;
            if (og + 1u == (tg + 1u) * nx) xb_add(&bar[XB_TOPGEN], 1u);
            else XB_SPIN(xb_ld(&bar[XB_TOPGEN]) == tg, bar);
            __builtin_amdgcn_fence(__ATOMIC_ACQUIRE, "agent");
            xb_add(&bar[XB_XGEN(b.x)], 1u);
            asm volatile("s_waitcnt vmcnt(0)" ::: "memory");
        } else {
            XB_SPIN(xb_ld(&bar[XB_XGEN(b.x)]) == gen, bar);
            __builtin_amdgcn_fence(__ATOMIC_ACQUIRE, "agent");
            asm volatile("s_waitcnt vmcnt(0)" ::: "memory");
        }
    }
    __syncthreads();
}

struct TrDesc { const float* W; bf16* WT; int K, N, item, ldt; };
__device__ __forceinline__ void tr_load(const TrDesc& d, int lane, f32x4 (&v)[16]) {
    const int nblk = d.N >> 6, kb = d.item / nblk, nb = d.item - kb * nblk, k0 = kb * 64, n0 = nb * 64, lr = lane >> 4, lc = lane & 15;
#pragma unroll
    for (int i = 0; i < 16; ++i) v[i] = __builtin_nontemporal_load((const f32x4*)(d.W + (size_t)(k0 + 4 * i + lr) * d.N + n0 + 4 * lc));
}
__device__ __forceinline__ void tr_to_lds(LAS float* scr, int lane, const f32x4 (&v)[16]) {
    const int lr = lane >> 4, lc = lane & 15;
#pragma unroll
    for (int i = 0; i < 16; ++i) { const int k = 4 * i + lr; *(LAS f32x4*)(scr + k * 64 + ((lc ^ ((k >> 3) & 7)) << 2)) = v[i]; }
}
__device__ __forceinline__ void tr_store(const TrDesc& d, LAS float* scr, int lane) {
    const int nblk = d.N >> 6, kb = d.item / nblk, nb = d.item - kb * nblk, k0 = kb * 64, n0 = nb * 64;
    const int c = lane & 7;
#pragma unroll
    for (int j = 0; j < 8; ++j) {
        const int n = (lane >> 3) + 8 * j;
        const LAS float* s = scr + (8 * c) * 64 + (((n >> 2) ^ c) << 2) + (n & 3);
        u32x4 o; o.x = pk2(s[0 * 64], s[1 * 64]); o.y = pk2(s[2 * 64], s[3 * 64]); o.z = pk2(s[4 * 64], s[5 * 64]); o.w = pk2(s[6 * 64], s[7 * 64]);
        *(u32x4*)(d.WT + (size_t)(n0 + n) * d.ldt + k0 + 8 * c) = o;
    }
}
__device__ __forceinline__ void mod_item(const Frame& F, LAS float* scr, int item) {
    const KArgs A = kargs();
    int lane = F.lane; asm volatile("" : "+v"(lane));
    const int l = item / 384, r = item - l * 384, cg = r >> 4, kc = r & 15;
    const float* cp = KIN(A, CP); const float* cs = KIN(A, CS);
    for (int idx = lane; idx < NMODB * 128; idx += 64) {
        const int b = idx >> 7, k = idx & 127;
        const float cv = b < NB_P ? cp[b * DM + kc * 128 + k] : cs[(b - NB_P) * DM + kc * 128 + k];
        scr[k * 16 + b] = cv * sigm(cv);
    }
    LDS_WAIT();
    f32x4 acc[NMODB];
#pragma unroll
    for (int b = 0; b < NMODB; ++b) acc[b] = (f32x4){0.f, 0.f, 0.f, 0.f};
    const float* wp = KIN(A, WADA) + (size_t)l * DM * 6144 + (size_t)(kc * 128) * 6144 + cg * 256 + lane * 4;
#pragma unroll 16
    for (int k = 0; k < 128; ++k) {
        const f32x4 w = __builtin_nontemporal_load((const f32x4*)(wp + (size_t)k * 6144));
        const f32x4 s0 = *(const LAS f32x4*)(scr + k * 16), s1 = *(const LAS f32x4*)(scr + k * 16 + 4), s2 = *(const LAS f32x4*)(scr + k * 16 + 8);
        acc[0] += s0[0] * w; acc[1] += s0[1] * w; acc[2] += s0[2] * w; acc[3] += s0[3] * w;
        acc[4] += s1[0] * w; acc[5] += s1[1] * w; acc[6] += s1[2] * w; acc[7] += s1[3] * w;
        acc[8] += s2[0] * w; acc[9] += s2[1] * w; acc[10] += s2[2] * w; acc[11] += s2[3] * w;
    }
    float* mp = (float*)(F.ws + WS_MODP) + ((size_t)(l * 16 + kc) * NMODB) * 6144 + cg * 256 + lane * 4;
#pragma unroll
    for (int b = 0; b < NMODB; ++b) *(f32x4*)(mp + (size_t)b * 6144) = acc[b];
    LDS_WAIT();
}
__device__ __forceinline__ void p0_prologue(const Frame& F) {
    const KArgs A = kargs();
    LAS float* scr = (LAS float*)(F.lds + F.wave * 16384);
    const int gw = F.vcu * 8 + F.wave, NGW = F.G * 8;
    constexpr int I_IN = 32 * 288, I_PA = 16 * 32, I_PB = 32 * 32, I_OUT = 32 * 32, I_RI = 16 * 4;
    constexpr int PER_L = I_IN + I_PA + I_PB + I_OUT + 2 * I_RI, NTR = DEPTH * PER_L, NMOD = DEPTH * 24 * 16;
    auto decode = [&](int it) -> TrDesc {
        TrDesc d; const int l = it / PER_L; int r = it - l * PER_L;
        if (r < I_IN) { d.W = KIN(A, WIN) + (size_t)l * DM * INC; d.K = DM; d.N = INC; d.ldt = DM; d.WT = (bf16*)(F.ws + WS_WIN) + (size_t)l * INC * DM; d.item = r; return d; } r -= I_IN;
        if (r < I_PA) { d.W = KIN(A, WPA) + (size_t)l * ATTW * DM; d.K = ATTW; d.N = DM; d.ldt = DM; d.WT = (bf16*)(F.ws + WS_WPA) + (size_t)l * DM * DM; d.item = r; return d; } r -= I_PA;
        if (r < I_PB) { d.W = KIN(A, WPB) + (size_t)l * DM * DM; d.K = DM; d.N = DM; d.ldt = DM; d.WT = (bf16*)(F.ws + WS_WPB) + (size_t)l * DM * DM; d.item = r; return d; } r -= I_PB;
        if (r < I_OUT) { d.W = KIN(A, WOUT) + (size_t)l * DM * DM; d.K = DM; d.N = DM; d.ldt = DM; d.WT = (bf16*)(F.ws + WS_WOUT) + (size_t)l * DM * DM; d.item = r; return d; } r -= I_OUT;
        if (r < I_RI) { const int nb = r >> 2; d.W = KIN(A, WR) + (size_t)(l * 16 + nb) * 16384; d.K = 128; d.N = 128; d.ldt = 128; d.WT = (bf16*)(F.ws + WS_WR) + (size_t)(l * 16 + nb) * 16384; d.item = r & 3; return d; } r -= I_RI;
        { const int nb = r >> 2; d.W = KIN(A, WI) + (size_t)(l * 16 + nb) * 16384; d.K = 128; d.N = 128; d.ldt = 128; d.WT = (bf16*)(F.ws + WS_WI) + (size_t)(l * 16 + nb) * 16384; d.item = r & 3; return d; }
    };
    {
        f32x4 va[16], vb[16]; int it = gw; TrDesc d0{}, d1{};
        if (it < NTR) { d0 = decode(it); tr_load(d0, F.lane, va); }
        if (it + NGW < NTR) { d1 = decode(it + NGW); tr_load(d1, F.lane, vb); }
#pragma unroll 1
        while (it < NTR) {
            int lane = F.lane; asm volatile("" : "+v"(lane));
            {
                tr_to_lds(scr, lane, va); LDS_WAIT();
                const int nx = it + 2 * NGW; TrDesc dn{};
                if (nx < NTR) { dn = decode(nx); tr_load(dn, lane, va); }
                tr_store(d0, scr, lane); LDS_WAIT();
                d0 = dn;
            }
            if (it + NGW < NTR) {
                tr_to_lds(scr, lane, vb); LDS_WAIT();
                const int nx = it + 3 * NGW; TrDesc dn{};
                if (nx < NTR) { dn = decode(nx); tr_load(dn, lane, vb); }
                tr_store(d1, scr, lane); LDS_WAIT();
                d1 = dn;
            }
            it += 2 * NGW;
        }
    }
#pragma unroll 1
    for (int it = gw; it < NMOD; it += NGW) mod_item(F, scr, it);
    {
        unsigned* q = (unsigned*)(F.ws + WS_CTL) + CW_P0Q;
        constexpr int CPR = KVC_REM / 512, NCLAIM = 4 * CPR / 4;
        static_assert(KVC_REM % 512 == 0, "copy chunks");
        int lane0 = F.lane; asm volatile("" : "+v"(lane0));
        unsigned gv = 0u; if (lane0 == 0) gv = __hip_atomic_fetch_add(q, 1u, __ATOMIC_RELAXED, __HIP_MEMORY_SCOPE_AGENT);
#pragma unroll 1
        for (;;) {
            const int cl = (int)__builtin_amdgcn_readfirstlane(gv);
            if (cl >= NCLAIM) break;
            gv = 0u; if (lane0 == 0) gv = __hip_atomic_fetch_add(q, 1u, __ATOMIC_RELAXED, __HIP_MEMORY_SCOPE_AGENT);
#pragma unroll 1
            for (int h = 0; h < 2; ++h) {
                f32x4 v[16]; f32x4* dp[16];
#pragma unroll
                for (int j = 0; j < 16; ++j) {
                    const int c = 4 * cl + 2 * h + (j >> 3), qq = c / CPR; const f32x4* sp;
                    kvc_map(A, F.out, (qq + 1) * KVC_LQ - KVC_REM + (c - qq * CPR) * 512 + (j & 7) * 64 + lane0, sp, dp[j]); v[j] = __builtin_nontemporal_load(sp); }
#pragma unroll
                for (int j = 0; j < 16; ++j) __builtin_nontemporal_store(v[j], dp[j]);
            }
        }
    }
}
__device__ __forceinline__ void p1_modreduce(const Frame& F) {
    const KArgs A = kargs();
    const int gt = (F.vcu * 8 + F.wave) * 64 + F.lane, NT = F.G * 512;
    const float* modp = (const float*)(F.ws + WS_MODP); float* mod = (float*)(F.ws + WS_MOD);
    for (int i = gt; i < DEPTH * NMODB * 6144; i += NT) {
        const int l = i / (NMODB * 6144), r = i - l * (NMODB * 6144), b = r / 6144, n = r - b * 6144;
        float s = KIN(A, BADA)[l * 6144 + n];
#pragma unroll
        for (int kc = 0; kc < 16; ++kc) s += modp[((size_t)(l * 16 + kc) * NMODB + b) * 6144 + n];
        mod[i] = s;
    }
}
__device__ __forceinline__ float sumsq8(const f32x4 (&v)[8]) {
    float ss = 0.f;
#pragma unroll
    for (int j = 0; j < 8; ++j) ss += (v[j][0] * v[j][0] + v[j][1] * v[j][1]) + (v[j][2] * v[j][2] + v[j][3] * v[j][3]);
    return ss;
}
__device__ __forceinline__ void phase_norm(const Frame& F, int l) {
    const KArgs A = kargs();
    const int gw = F.vcu * 8 + F.wave, NGW = F.G * 8, lane = F.lane;
    bf16* H = (bf16*)(F.ws + WS_H); const float* X = (const float*)(F.ws + WS_X); const float* mod = (const float*)(F.ws + WS_MOD);
    const f32x4* g4 = (const f32x4*)(KIN(A, NORMG) + l * DM);
#pragma unroll 1
    for (int r0 = 4 * gw; r0 < MP + 4 * MS; r0 += 4 * NGW) {
        const bool prompt = r0 < MP; const int rbase = prompt ? r0 : MP + ((r0 - MP) >> 2), nrow = prompt ? 4 : 1;
        const int b = prompt ? (rbase >> 11) : NB_P + ((rbase - MP) >> 2);
        const float* xbase = (l == 0) ? (prompt ? KIN(A, XP) + (size_t)rbase * DM : KIN(A, XS) + (size_t)(rbase - MP) * DM) : X + (size_t)rbase * DM;
        const f32x4* sh4 = (const f32x4*)(mod + (size_t)(l * NMODB + b) * 6144); const f32x4* sc4 = sh4 + 512;
        f32x4 v[8], vn[8], G[8], S[8];
#pragma unroll
        for (int j = 0; j < 8; ++j) v[j] = ((const f32x4*)xbase)[lane + 64 * j];
#pragma unroll
        for (int j = 0; j < 8; ++j) { G[j] = g4[lane + 64 * j] * (sc4[lane + 64 * j] + 1.0f); S[j] = sh4[lane + 64 * j]; }
#pragma unroll
        for (int k = 0; k < 4; ++k) if (k < nrow) {
            if (k + 1 < nrow) {
#pragma unroll
                for (int j = 0; j < 8; ++j) vn[j] = ((const f32x4*)(xbase + (size_t)(k + 1) * DM))[lane + 64 * j];
            }
            const float rstd = 1.0f / sqrtf(wave_sum(sumsq8(v), lane) * (1.0f / DM) + RMS_EPS);
            u32x2* ho = (u32x2*)(H + (size_t)(rbase + k) * DM) + lane;
#pragma unroll
            for (int j = 0; j < 8; ++j) { const f32x4 o = (v[j] * rstd) * G[j] + S[j]; ho[64 * j] = (u32x2){pk2(o[0], o[1]), pk2(o[2], o[3])}; }
#pragma unroll
            for (int j = 0; j < 8; ++j) v[j] = vn[j];
        }
    }
}
__device__ __forceinline__ void phase_final(const Frame& F) {
    const KArgs A = kargs();
    const int gw = F.vcu * 8 + F.wave, NGW = F.G * 8, lane = F.lane;
    const float* X = (const float*)(F.ws + WS_X); const f32x4* g4 = (const f32x4*)KIN(A, FING);
    f32x4 G[8];
#pragma unroll
    for (int j = 0; j < 8; ++j) G[j] = g4[lane + 64 * j];
#pragma unroll 1
    for (int r0 = 4 * gw; r0 < MP + 4 * MS; r0 += 4 * NGW) {
        const bool prompt = r0 < MP; const int rbase = prompt ? r0 : MP + ((r0 - MP) >> 2), nrow = prompt ? 4 : 1;
        const float* xbase = X + (size_t)rbase * DM;
        float* ybase = (float*)F.out + (prompt ? O_YP + (size_t)rbase * DM : O_YS + (size_t)(rbase - MP) * DM);
        f32x4 v[8], vn[8];
#pragma unroll
        for (int j = 0; j < 8; ++j) v[j] = ((const f32x4*)xbase)[lane + 64 * j];
#pragma unroll
        for (int k = 0; k < 4; ++k) if (k < nrow) {
            if (k + 1 < nrow) {
#pragma unroll
                for (int j = 0; j < 8; ++j) vn[j] = ((const f32x4*)(xbase + (size_t)(k + 1) * DM))[lane + 64 * j];
            }
            const float rstd = 1.0f / sqrtf(wave_sum(sumsq8(v), lane) * (1.0f / DM) + RMS_EPS);
            f32x4* yo = (f32x4*)(ybase + (size_t)k * DM) + lane;
#pragma unroll
            for (int j = 0; j < 8; ++j) yo[64 * j] = (v[j] * rstd) * G[j];
#pragma unroll
            for (int j = 0; j < 8; ++j) v[j] = vn[j];
        }
    }
}

__device__ __forceinline__ pg8::f32x4 mfma16(bf16x8 a, bf16x8 b, pg8::f32x4 c) { return __builtin_amdgcn_mfma_f32_16x16x32_bf16(a, b, c, 0, 0, 0); }
__device__ __forceinline__ s16x4 tr16(const LAS unsigned char* p) { return __builtin_bit_cast(s16x4, __builtin_amdgcn_ds_read_tr16_b64_v4i16((LAS s16x4*)p)); }

struct AttnU { int b, g, h, cls, n; };
__device__ __forceinline__ AttnU attn_decode(int id) {
    AttnU u; const int bh = id & 31, x = id >> 5, blk = x & 15; u.g = x >> 4; u.b = bh >> 3; u.h = bh & 7;
    u.cls = u.g == 0 ? 0 : (u.g == 1 ? (blk & 3) : blk); u.n = u.g == 0 ? blk : (u.g == 1 ? (blk >> 2) : 0); return u;
}
__device__ __forceinline__ void attn_request(const Frame& F, const AttnU& u, int tid, int wave, u32x4 (&kreg)[8], bf16x8 (&qf)[4]) {
    const bf16* Q = (const bf16*)(F.ws + WS_Q); const bf16* K = (const bf16*)(F.ws + WS_K);
    const int dil = u.g == 0 ? 1 : (u.g == 1 ? 4 : 16), gh = u.g * 8 + u.h, kk_lo = (u.n == 0) ? 128 : 0, npass = (256 - kk_lo) >> 5;
    const int c16 = tid & 15, rr = tid >> 4, lane = tid & 63;
#pragma unroll
    for (int p = 0; p < 8; ++p) if (p < npass) {
        const int kk = kk_lo + 32 * p + rr, uk = 128 * (u.n - 1) + kk;
        const size_t off = ((size_t)(u.b * TT + uk * dil + u.cls)) * QKVW + gh * 128 + c16 * 8;
        kreg[p] = *(const u32x4*)(K + off);
    }
    const size_t qrow = (size_t)(u.b * TT + (128 * u.n + 16 * wave + (lane & 15)) * dil + u.cls);
#pragma unroll
    for (int ks = 0; ks < 4; ++ks) qf[ks] = *(const bf16x8*)(Q + qrow * QKVW + gh * 128 + 32 * ks + 8 * (lane >> 4));
}
template <int NT>
__device__ __forceinline__ void attn_compute(const LAS unsigned char* Kl, const LAS unsigned char* Vl, const LAS float* biasP, const bf16x8 (&qf)[4], int kkb, int iq, int lane,
                                             bf16* orow, float* lsep, const f32x4 (&cv)[KVC_RIDE > 0 ? KVC_RIDE : 1], KArgs A, GAS float* outp, int cbase, int cgrp) {
    const int q = lane & 15, gq = lane >> 4;
    pg8::f32x4 st[NT];
    {
        bf16x8 kf[2][4];
#define ATT_LDK(buf, t_) do { const int kk_ = kkb + 16 * (t_) + q; \
            _Pragma("unroll") for (int ks_ = 0; ks_ < 4; ++ks_) kf[buf][ks_] = *(const LAS bf16x8*)(Kl + kk_ * 256 + (((4 * ks_ + gq) ^ (kk_ & 15)) << 4)); } while (0)
        ATT_LDK(0, 0);
#pragma unroll
        for (int t = 0; t < NT; ++t) {
            if (t + 1 < NT) ATT_LDK((t + 1) & 1, t + 1);
            __builtin_amdgcn_sched_barrier(0);
            st[t] = (pg8::f32x4){0.f, 0.f, 0.f, 0.f};
#pragma unroll
            for (int ks = 0; ks < 4; ++ks) st[t] = mfma16(kf[t & 1][ks], qf[ks], st[t]);
            __builtin_amdgcn_sched_barrier(0);
        }
#undef ATT_LDK
    }
    const LAS float* bp = biasP + (iq + 128 - kkb - 4 * gq + 160);
    float mx = -1e30f;
#pragma unroll
    for (int t = 0; t < NT; ++t)
#pragma unroll
        for (int r = 0; r < 4; ++r) { const float lg = st[t][r] + bp[-(16 * t + r)]; st[t][r] = lg; mx = fmaxf(mx, lg); }
    mx = fmaxf(mx, shfl_x(mx, 16, lane)); mx = fmaxf(mx, shfl_x(mx, 32, lane));
    float sum = 0.f;
#pragma unroll
    for (int t = 0; t < NT; ++t)
#pragma unroll
        for (int r = 0; r < 4; ++r) { const float p = __builtin_amdgcn_exp2f(st[t][r] - mx); st[t][r] = p; sum += p; }
    sum += shfl_x(sum, 16, lane); sum += shfl_x(sum, 32, lane);
    if (KVC_RIDE == 4) asm volatile("s_waitcnt vmcnt(4)" ::: "memory"); else if (KVC_RIDE == 6) asm volatile("s_waitcnt vmcnt(6)" ::: "memory"); else asm volatile("s_waitcnt vmcnt(0)" ::: "memory");
    __builtin_amdgcn_s_barrier(); asm volatile("" ::: "memory");
    pg8::f32x4 o[8];
#pragma unroll
    for (int dt = 0; dt < 8; ++dt) o[dt] = (pg8::f32x4){0.f, 0.f, 0.f, 0.f};
    {
        s16x4 vlo[2][4], vhi[2][4];
#define ATT_LDV(buf, h_) do { const int ra_ = kkb + 32 * ((h_) >> 1) + 4 * gq + (q >> 2); const LAS unsigned char* va_ = Vl + ra_ * 256 + (lane & 3) * 8; \
            _Pragma("unroll") for (int d_ = 0; d_ < 4; ++d_) { const int sw_ = ((4 * ((h_) & 1) + d_) ^ (ra_ & 7)) << 5; vlo[buf][d_] = tr16(va_ + sw_); vhi[buf][d_] = tr16(va_ + 16 * 256 + sw_); } } while (0)
        ATT_LDV(0, 0);
#pragma unroll
        for (int hs = 0; hs < NT; ++hs) {
            if (hs + 1 < NT) ATT_LDV((hs + 1) & 1, hs + 1);
            const int s = hs >> 1;
            const unsigned p0 = pk2(st[2 * s][0], st[2 * s][1]), p1 = pk2(st[2 * s][2], st[2 * s][3]), p2 = pk2(st[2 * s + 1][0], st[2 * s + 1][1]), p3 = pk2(st[2 * s + 1][2], st[2 * s + 1][3]);
            const bf16x8 pf = __builtin_bit_cast(bf16x8, (u32x4){p0, p1, p2, p3});
            __builtin_amdgcn_sched_barrier(0);
#pragma unroll
            for (int d = 0; d < 4; ++d) {
                const s16x4 lo = vlo[hs & 1][d], hi = vhi[hs & 1][d];
                const bf16x8 vf = (bf16x8){lo[0], lo[1], lo[2], lo[3], hi[0], hi[1], hi[2], hi[3]};
                o[4 * (hs & 1) + d] = mfma16(vf, pf, o[4 * (hs & 1) + d]);
            }
            __builtin_amdgcn_sched_barrier(0);
        }
#undef ATT_LDV
    }
    const float inv = 1.0f / sum;
#pragma unroll
    for (int dt = 0; dt < 8; ++dt) *(u32x2*)(orow + 16 * dt) = (u32x2){pk2(o[dt][0] * inv, o[dt][1] * inv), pk2(o[dt][2] * inv, o[dt][3] * inv)};
    if (gq == 0) *lsep = mx + __builtin_amdgcn_logf(sum);
#pragma unroll
    for (int j = 0; j < KVC_RIDE; ++j) { const f32x4* sp; f32x4* dp; kvc_map1(A, outp, cgrp, cbase + j * 512, sp, dp); __builtin_nontemporal_store(cv[j], dp); }
}
__device__ __forceinline__ void attn_phase(const Frame& F, int l) {
    const KArgs A = kargs();
    const int wave = F.wave;
    bf16* OG = (bf16*)(F.ws + WS_OG); float* LSE = (float*)(F.ws + WS_LSE);
    LAS unsigned char* Kl = F.lds; LAS unsigned char* Vl = F.lds + 65536; LAS float* biasP = (LAS float*)(F.lds + LDSBIAS_OFF);
    u32x4 kreg[8]; bf16x8 qn[4];
    if (F.vcu < 1536) { const AttnU u0 = attn_decode(F.vcu); attn_request(F, u0, F.tid, wave, kreg, qn); }
    const bool fixed_h = (F.G & 31) == 0;
    if (fixed_h) {
        const int h = F.vcu & 7;
        for (int e = F.tid; e < 3 * 448; e += 512) { const int g = e / 448, i = e - g * 448, du = i - 160, dil = g == 0 ? 1 : (g == 1 ? 4 : 16);
            biasP[e] = (du >= 0 && du <= 128) ? KIN(A, RELB)[t5_bucket(du * dil) * 24 + g * 8 + h] * LOG2E : -1e30f; }
    }
#pragma unroll 1
    for (int id = F.vcu; id < 1536; id += F.G) {
        int tid_ = F.tid; asm volatile("" : "+v"(tid_));
        const int tid = tid_, lane = tid & 63;
        const AttnU u = attn_decode(id);
        const int dil = u.g == 0 ? 1 : (u.g == 1 ? 4 : 16), gh = u.g * 8 + u.h, kk_lo = (u.n == 0) ? 128 : 0, npass = (256 - kk_lo) >> 5;
        {
            const int c16 = tid & 15, rr = tid >> 4;
            if (!fixed_h && tid < 448) { const int du = tid - 160; biasP[u.g * 448 + tid] = (du >= 0 && du <= 128) ? KIN(A, RELB)[t5_bucket(du * dil) * 24 + gh] * LOG2E : -1e30f; }
#pragma unroll
            for (int p = 0; p < 8; ++p) if (p < npass) {
                const int kk = kk_lo + 32 * p + rr;
                *(LAS u32x4*)(Kl + kk * 256 + ((c16 ^ (kk & 15)) << 4)) = kreg[p];
            }
        }
        bf16x8 qf[4];
#pragma unroll
        for (int ks = 0; ks < 4; ++ks) qf[ks] = qn[ks];
        {
            const bf16* V = (const bf16*)(F.ws + WS_V);
#pragma unroll
            for (int j = 0; j < 8; ++j) if (j < npass) {
                const int kk0 = kk_lo + 4 * (wave * npass + j), row = kk0 + (lane >> 4), sl = lane & 15, c16 = ((((sl >> 1) ^ (row & 7)) << 1) | (sl & 1));
                const bf16* gsrc = V + ((size_t)(u.b * TT + (128 * (u.n - 1) + row) * dil + u.cls)) * QKVW + gh * 128 + c16 * 8;
                __builtin_amdgcn_global_load_lds((const unsigned*)gsrc, (LAS unsigned*)(Vl + kk0 * 256), 16, 0, 0);
            }
        }
        asm volatile("s_waitcnt lgkmcnt(0)" ::: "memory"); __builtin_amdgcn_s_barrier(); asm volatile("" ::: "memory");
        if (id + F.G < 1536) { const AttnU un = attn_decode(id + F.G); attn_request(F, un, tid, wave, kreg, qn); }
        const int iq = 16 * wave + (lane & 15);
        const size_t qrow = (size_t)(u.b * TT + (128 * u.n + iq) * dil + u.cls);
        bf16* orow = OG + ((size_t)u.g * MPAD + qrow) * ATTW + u.h * 128 + 4 * (lane >> 4);
        float* lsep = LSE + ((size_t)u.g * MPAD + qrow) * 8 + u.h;
        f32x4 cv[KVC_RIDE > 0 ? KVC_RIDE : 1];
        const int cbase = l * KVC_LQ + KVC_LAYER + id * (512 * KVC_RIDE) + tid;
        const int cgrp = l == 0 ? 1 : 2;
        __builtin_amdgcn_sched_barrier(0);
#pragma unroll
        for (int j = 0; j < KVC_RIDE; ++j) { const f32x4* sp; f32x4* dp; kvc_map1(A, F.out, cgrp, cbase + j * 512, sp, dp); cv[j] = __builtin_nontemporal_load(sp); }
        __builtin_amdgcn_sched_barrier(0);
        if (u.n != 0) attn_compute<10>(Kl, Vl, biasP + u.g * 448, qf, 32 * (wave >> 1), iq, lane, orow, lsep, cv, A, F.out, cbase, cgrp);
        else attn_compute<8>(Kl, Vl, biasP + u.g * 448, qf, 128, iq, lane, orow, lsep, cv, A, F.out, cbase, cgrp);
        asm volatile("s_waitcnt lgkmcnt(0)" ::: "memory"); __builtin_amdgcn_s_barrier(); asm volatile("" ::: "memory");
    }
    __syncthreads();
}

__device__ __forceinline__ void attn_sample_task(const Frame& F, int l, int task) {
    const KArgs A = kargs();
    const float* relb = KIN(A, RELB);
    int lane_ = F.lane; asm volatile("" : "+v"(lane_));
    const int lane = lane_, s = task & 3, gh = (task >> 2) % 24, bs = task / 96, g = gh >> 3, h = gh & 7;
    const int dil = g == 0 ? 1 : (g == 1 ? 4 : 16), Wg = g == 0 ? 128 : (g == 1 ? 512 : 2048);
    const float* cache = (g == 0 ? KIN(A, C0) : (g == 1 ? KIN(A, C1) : KIN(A, C2))) + ((size_t)(l * NB_S + bs) * Wg) * KVROW + h * 128;
    const float* fresh = (const float*)F.out + (g == 0 ? O_KVS0 : (g == 1 ? O_KVS1 : O_KVS2)) + ((size_t)(l * NB_S + bs) * Wg) * KVROW + h * 128;
    const int row = MP + bs * 4 + s, hl = lane >> 5, d4 = (lane & 31) * 4;
    const bf16* Q = (const bf16*)(F.ws + WS_Q);
    const u32x2 qw = *(const u32x2*)(Q + (size_t)row * QKVW + gh * 128 + d4);
    const f32x4 q4 = (f32x4){bflo(qw.x), bfhi(qw.x), bflo(qw.y), bfhi(qw.y)};
    float mx = -1e30f, sum = 0.f; f32x4 acc = (f32x4){0.f, 0.f, 0.f, 0.f};
#pragma unroll 1
    for (int jb = 0; jb < 65; jb += 13) {
        f32x4 kv[13], vv[13]; float bsv[13];
#pragma unroll
        for (int u = 0; u < 13; ++u) {
            const int j = 2 * (jb + u) + hl, jc = j <= 128 ? j : 0, idx = Wg + s - jc * dil;
            const float* rowp = (idx < Wg ? cache + (size_t)idx * KVROW : fresh + (size_t)(idx - 4) * KVROW) + d4;
            kv[u] = *(const f32x4*)rowp; vv[u] = *(const f32x4*)(rowp + 1024); bsv[u] = relb[t5_bucket(jc * dil) * 24 + gh];
        }
        float lg[13], bm = -1e30f;
#pragma unroll
        for (int u = 0; u < 13; ++u) {
            const int j = 2 * (jb + u) + hl;
            float d = (kv[u][0] * q4[0] + kv[u][1] * q4[1]) + (kv[u][2] * q4[2] + kv[u][3] * q4[3]);
#pragma unroll
            for (int o = 1; o < 32; o <<= 1) d += shfl_x(d, o, lane);
            lg[u] = j <= 128 ? d + bsv[u] * LOG2E : -1e30f; bm = fmaxf(bm, lg[u]);
        }
        bm = fmaxf(bm, shfl_x(bm, 32, lane));
        const float mn = fmaxf(mx, bm), sc = __builtin_amdgcn_exp2f(mx - mn);
        acc = acc * sc; sum *= sc; mx = mn;
#pragma unroll
        for (int u = 0; u < 13; ++u) { const float p = __builtin_amdgcn_exp2f(lg[u] - mn); sum += p; acc += p * vv[u]; }
    }
    sum += shfl_x(sum, 32, lane);
#pragma unroll
    for (int e = 0; e < 4; ++e) acc[e] += shfl_x(acc[e], 32, lane);
    const float inv = 1.0f / sum;
    if (lane < 32) *(u32x2*)((bf16*)(F.ws + WS_OG) + ((size_t)g * MPAD + row) * ATTW + h * 128 + d4) = (u32x2){pk2(acc[0] * inv, acc[1] * inv), pk2(acc[2] * inv, acc[3] * inv)};
    if (lane == 0) ((float*)(F.ws + WS_LSE))[((size_t)g * MPAD + row) * 8 + h] = mx + __builtin_amdgcn_logf(sum);
}

__device__ __forceinline__ float one_minus_sq_exp(float x2, float a) {
    const float pser = -x2 * (1.0f + x2 * (0.5f + x2 * (0.16666667f + x2 * (0.041666668f + x2 * (0.0083333338f + x2 * 0.0013888889f)))));
    return x2 > -0.25f ? pser : 1.0f - a * a;
}
__device__ __forceinline__ void lru_unit(const Frame& F, int l, int b, int nb, int js, int uid) {
    const KArgs A = kargs();
    int tid_ = F.tid; asm volatile("" : "+v"(tid_));
    const int tid = tid_, lane = tid & 63, wave = F.wave, c0 = nb * 128, q = lane & 15, gq = lane >> 4;
    const bf16* XL = (const bf16*)(F.ws + WS_XL); const bf16* ZL = (const bf16*)(F.ws + WS_ZL); bf16* AL = (bf16*)(F.ws + WS_AL);
    LAS unsigned char* wl = F.lds + 65536;
    LAS float* wtot = (LAS float*)(F.lds + 65536 + 16384);
#pragma unroll
    for (int i = 0; i < 2; ++i) {
        const int ci = tid + 512 * i, dr = ci >> 4, ch = ci & 15;
        const bf16* src = (const bf16*)(F.ws + (dr < 32 ? WS_WR : WS_WI)) + ((size_t)(l * 16 + nb) * 128 + js * 32 + (dr & 31)) * 128 + 8 * ch;
        *(LAS u32x4*)(wl + dr * 256 + ((ch ^ (dr & 15)) << 4)) = *(const u32x4*)src;
    }
    float br[2], bi[2], sp8[2], carry[2];
#pragma unroll
    for (int cc = 0; cc < 2; ++cc) {
        const int ch = l * DM + c0 + js * 32 + 16 * cc + q;
        br[cc] = KIN(A, BR)[ch]; bi[cc] = KIN(A, BI)[ch]; sp8[cc] = 8.0f * log1pf(__expf(-KIN(A, LAM)[ch])); carry[cc] = 0.f;
    }
    const int tg = tid >> 4, chn = tid & 15;
    float cw[4][8], cb[8];
#pragma unroll
    for (int tap = 0; tap < 4; ++tap) { const f32x4 a = *(const f32x4*)(KIN(A, CONVW) + (size_t)(l * 4 + tap) * DM + c0 + 8 * chn), bq = *(const f32x4*)(KIN(A, CONVW) + (size_t)(l * 4 + tap) * DM + c0 + 8 * chn + 4);
        cw[tap][0] = a[0]; cw[tap][1] = a[1]; cw[tap][2] = a[2]; cw[tap][3] = a[3]; cw[tap][4] = bq[0]; cw[tap][5] = bq[1]; cw[tap][6] = bq[2]; cw[tap][7] = bq[3]; }
    { const f32x4 a = *(const f32x4*)(KIN(A, CONVB) + l * DM + c0 + 8 * chn), bq = *(const f32x4*)(KIN(A, CONVB) + l * DM + c0 + 8 * chn + 4);
      cb[0] = a[0]; cb[1] = a[1]; cb[2] = a[2]; cb[3] = a[3]; cb[4] = bq[0]; cb[5] = bq[1]; cb[6] = bq[2]; cb[7] = bq[3]; }
    u32x4 xw[7];
#define LRU_LOADX(ckk) do { _Pragma("unroll") for (int i = 0; i < 7; ++i) { const int t = (ckk) * 128 + 4 * tg - 3 + i; xw[i] = (u32x4){0u, 0u, 0u, 0u}; \
        if (t >= 0) xw[i] = *(const u32x4*)(XL + (size_t)(b * TT + t) * DM + c0 + 8 * chn); } } while (0)
    LRU_LOADX(0);
#pragma unroll 1
    for (int ck = 0; ck < 16; ++ck) {
        const int t0 = ck * 128;
        LAS unsigned char* xcL = F.lds + (ck & 1) * 32768;
        LAS float* wt = wtot + (ck & 1) * 512;
        {
            float x[7][8];
#pragma unroll
            for (int i = 0; i < 7; ++i) {
                const u32x4 w = xw[i];
                x[i][0] = bflo(w.x); x[i][1] = bfhi(w.x); x[i][2] = bflo(w.y); x[i][3] = bfhi(w.y); x[i][4] = bflo(w.z); x[i][5] = bfhi(w.z); x[i][6] = bflo(w.w); x[i][7] = bfhi(w.w);
            }
#pragma unroll
            for (int tt = 0; tt < 4; ++tt) {
                float y[8];
#pragma unroll
                for (int e = 0; e < 8; ++e) y[e] = cb[e] + ((cw[0][e] * x[tt][e] + cw[1][e] * x[tt + 1][e]) + (cw[2][e] * x[tt + 2][e] + cw[3][e] * x[tt + 3][e]));
                const int tok = 4 * tg + tt;
                *(LAS u32x4*)(xcL + tok * 256 + ((chn ^ (tok & 15)) << 4)) = (u32x4){pk2(y[0], y[1]), pk2(y[2], y[3]), pk2(y[4], y[5]), pk2(y[6], y[7])};
            }
        }
        __syncthreads();
        if (ck + 1 < 16) LRU_LOADX(ck + 1);
        f32x4 rv[KVC_LRIDE > 0 ? KVC_LRIDE : 1];
        const int rbase = l * KVC_LQ + KVC_LAYER + KVC_ATT + (uid * 16 + ck) * (512 * KVC_LRIDE) + tid, rgrp = l == 0 ? 1 : 2;
#pragma unroll
        for (int j = 0; j < KVC_LRIDE; ++j) { const f32x4* sp; f32x4* dp; kvc_map1(A, F.out, rgrp, rbase + j * 512, sp, dp); rv[j] = __builtin_nontemporal_load(sp); }
        bf16 zraw[2][4];
#pragma unroll
        for (int cc = 0; cc < 2; ++cc)
#pragma unroll
            for (int r = 0; r < 4; ++r) zraw[cc][r] = ZL[(size_t)(b * TT + t0 + 16 * wave + 4 * gq + r) * DM + c0 + js * 32 + 16 * cc + q];
        pg8::f32x4 acc[4];
        {
            const int tok = 16 * wave + q;
            bf16x8 af[4], bw[2][4];
#pragma unroll
            for (int ks = 0; ks < 4; ++ks) af[ks] = *(const LAS bf16x8*)(xcL + tok * 256 + (((4 * ks + gq) ^ (tok & 15)) << 4));
#pragma unroll
            for (int np = 0; np < 2; ++np) {
#pragma unroll
                for (int j = 0; j < 2; ++j)
#pragma unroll
                    for (int ks = 0; ks < 4; ++ks) bw[j][ks] = *(const LAS bf16x8*)(wl + (32 * np + 16 * j + q) * 256 + (((4 * ks + gq) ^ q) << 4));
                __builtin_amdgcn_sched_barrier(0);
#pragma unroll
                for (int j = 0; j < 2; ++j) { acc[2 * np + j] = (pg8::f32x4){0.f, 0.f, 0.f, 0.f};
#pragma unroll
                    for (int ks = 0; ks < 4; ++ks) acc[2 * np + j] = mfma16(af[ks], bw[j][ks], acc[2 * np + j]); }
                __builtin_amdgcn_sched_barrier(0);
            }
        }
        float pp[2][4], sv[2][4], Pex[2], Sex[2];
#pragma unroll
        for (int cc = 0; cc < 2; ++cc) {
            const int cidx = js * 32 + 16 * cc + q;
            float a[4], u[4];
#pragma unroll
            for (int r = 0; r < 4; ++r) {
                const int tok = 16 * wave + 4 * gq + r;
                const float xv = bf1(*(const LAS bf16*)(xcL + tok * 256 + (((cidx >> 3) ^ (tok & 15)) << 4) + (cidx & 7) * 2));
                const float rg = sigm(acc[cc][r] + br[cc]), ig = sigm(acc[2 + cc][r] + bi[cc]);
                const float la = -sp8[cc] * rg;
                a[r] = __expf(la); u[r] = __builtin_amdgcn_sqrtf(one_minus_sq_exp(2.0f * la, a[r])) * (ig * xv);
            }
            pp[cc][0] = a[0]; sv[cc][0] = u[0];
#pragma unroll
            for (int r = 1; r < 4; ++r) { pp[cc][r] = pp[cc][r - 1] * a[r]; sv[cc][r] = a[r] * sv[cc][r - 1] + u[r]; }
            float P = pp[cc][3], S = sv[cc][3];
            { const float Pn = shfl_u(P, 16, lane), Sn = shfl_u(S, 16, lane); if (gq >= 1) { S = P * Sn + S; P = P * Pn; } }
            { const float Pn = shfl_u(P, 32, lane), Sn = shfl_u(S, 32, lane); if (gq >= 2) { S = P * Sn + S; P = P * Pn; } }
            { const float Pn = shfl_u(P, 16, lane), Sn = shfl_u(S, 16, lane); Pex[cc] = gq >= 1 ? Pn : 1.0f; Sex[cc] = gq >= 1 ? Sn : 0.0f; }
            if (gq == 3) { wt[(wave * 2 + cc) * 32 + 2 * q] = P; wt[(wave * 2 + cc) * 32 + 2 * q + 1] = S; }
        }
        __syncthreads();
#pragma unroll
        for (int cc = 0; cc < 2; ++cc) {
            float hin = carry[cc], hall = carry[cc];
#pragma unroll
            for (int w = 0; w < 8; ++w) {
                const float P = wt[(w * 2 + cc) * 32 + 2 * q], S = wt[(w * 2 + cc) * 32 + 2 * q + 1];
                hall = P * hall + S; if (w < wave) hin = hall;
            }
            carry[cc] = hall;
            const float hl = Pex[cc] * hin + Sex[cc];
            const int ch = c0 + js * 32 + 16 * cc + q;
#pragma unroll
            for (int r = 0; r < 4; ++r) {
                const float hv = pp[cc][r] * hl + sv[cc][r];
                const size_t ro = (size_t)(b * TT + t0 + 16 * wave + 4 * gq + r) * DM + ch;
                AL[ro] = (bf16)(pk2(hv * bf1(zraw[cc][r]), 0.f) & 0xffffu);
                if (ck == 15 && wave == 7 && gq == 3 && r == 3) F.out[O_HP + (size_t)(l * NB_P + b) * DM + ch] = hv;
            }
        }
#pragma unroll
        for (int j = 0; j < KVC_LRIDE; ++j) { const f32x4* sp; f32x4* dp; kvc_map1(A, F.out, rgrp, rbase + j * 512, sp, dp); __builtin_nontemporal_store(rv[j], dp); }
    }
#undef LRU_LOADX
    __syncthreads();
}
__device__ __forceinline__ void lru_sample_unit(const Frame& F, int l, int bs, int nb, int dq) {
    const KArgs A = kargs();
    int tid_ = F.tid; asm volatile("" : "+v"(tid_));
    const int tid = tid_, lane = tid & 63, c0 = nb * 128;
    LAS float* xc = (LAS float*)F.lds;
    const bf16* XL = (const bf16*)(F.ws + WS_XL);
    {
        const int t = tid >> 7, c = tid & 127;
        const float cb = KIN(A, CONVB)[l * DM + c0 + c];
        float xv[2][4], cw[4];
#pragma unroll
        for (int tap = 0; tap < 4; ++tap) {
            const int p = t + tap;
            cw[tap] = KIN(A, CONVW)[(size_t)(l * 4 + tap) * DM + c0 + c];
#pragma unroll
            for (int h = 0; h < 2; ++h) { const int bb = bs + 4 * h;
                xv[h][tap] = p < 3 ? KIN(A, SCONV)[((size_t)(l * NB_S + bb) * 3 + p) * DM + c0 + c] : bf1(XL[(size_t)(MP + bb * 4 + (p - 3)) * DM + c0 + c]); }
        }
#pragma unroll
        for (int h = 0; h < 2; ++h) { float y = cb;
#pragma unroll
            for (int tap = 0; tap < 4; ++tap) y += cw[tap] * xv[h][tap];
            xc[h * 512 + t * 128 + c] = y; }
    }
    const int cq = tid & 3, t = (tid >> 2) & 3, d = dq * 32 + (tid >> 4), chg = l * DM + c0 + d;
    const bf16* wr = (const bf16*)(F.ws + WS_WR) + ((size_t)(l * 16 + nb) * 128 + d) * 128 + 32 * cq;
    const bf16* wi = (const bf16*)(F.ws + WS_WI) + ((size_t)(l * 16 + nb) * 128 + d) * 128 + 32 * cq;
    u32x4 wrv[4], wiv[4];
#pragma unroll
    for (int i = 0; i < 4; ++i) { wrv[i] = *(const u32x4*)(wr + 8 * i); wiv[i] = *(const u32x4*)(wi + 8 * i); }
    const float brv = KIN(A, BR)[chg], biv = KIN(A, BI)[chg], sp8 = 8.0f * log1pf(__expf(-KIN(A, LAM)[chg]));
    float h0[2], zv[2]; size_t ro[2];
#pragma unroll
    for (int h = 0; h < 2; ++h) { const int bb = bs + 4 * h;
        h0[h] = KIN(A, SH)[(size_t)(l * NB_S + bb) * DM + c0 + d];
        ro[h] = (size_t)(MP + bb * 4 + t) * DM + c0 + d;
        zv[h] = bf1(((const bf16*)(F.ws + WS_ZL))[ro[h]]); }
    __syncthreads();
#pragma unroll
    for (int h = 0; h < 2; ++h) {
        const LAS float* xh = xc + h * 512;
        float rp = 0.f, ip = 0.f;
#pragma unroll
        for (int i = 0; i < 4; ++i) {
            const f32x4 xa = *(const LAS f32x4*)(xh + t * 128 + 32 * cq + 8 * i), xb = *(const LAS f32x4*)(xh + t * 128 + 32 * cq + 8 * i + 4);
            rp += (xa[0] * bflo(wrv[i].x) + xa[1] * bfhi(wrv[i].x)) + (xa[2] * bflo(wrv[i].y) + xa[3] * bfhi(wrv[i].y)) + (xb[0] * bflo(wrv[i].z) + xb[1] * bfhi(wrv[i].z)) + (xb[2] * bflo(wrv[i].w) + xb[3] * bfhi(wrv[i].w));
            ip += (xa[0] * bflo(wiv[i].x) + xa[1] * bfhi(wiv[i].x)) + (xa[2] * bflo(wiv[i].y) + xa[3] * bfhi(wiv[i].y)) + (xb[0] * bflo(wiv[i].z) + xb[1] * bfhi(wiv[i].z)) + (xb[2] * bflo(wiv[i].w) + xb[3] * bfhi(wiv[i].w));
        }
        rp += shfl_x(rp, 1, lane); rp += shfl_x(rp, 2, lane); ip += shfl_x(ip, 1, lane); ip += shfl_x(ip, 2, lane);
        const float rg = sigm(rp + brv), ig = sigm(ip + biv), la = -sp8 * rg;
        float P = __expf(la), S = __builtin_amdgcn_sqrtf(one_minus_sq_exp(2.0f * la, P)) * (ig * xh[t * 128 + d]);
        { const float Pn = shfl_u(P, 4, lane), Sn = shfl_u(S, 4, lane); if (t >= 1) { S = P * Sn + S; P = P * Pn; } }
        { const float Pn = shfl_u(P, 8, lane), Sn = shfl_u(S, 8, lane); if (t >= 2) { S = P * Sn + S; P = P * Pn; } }
        const float hv = P * h0[h] + S;
        if (cq == 0) {
            ((bf16*)(F.ws + WS_AL))[ro[h]] = (bf16)(pk2(hv * zv[h], 0.f) & 0xffffu);
            if (t == 3) F.out[O_HS + (size_t)(l * NB_S + bs + 4 * h) * DM + c0 + d] = hv;
        }
    }
    __syncthreads();
}
#ifndef PROBE_SUB
#define PROBE_SUB 0
#endif
__device__ __forceinline__ void phase_mix(const Frame& F, int l) {
#pragma unroll 1
    for (int rep = 0; rep < (PROBE_SUB == 1 ? 2 : 1); ++rep) attn_phase(F, l);
#pragma unroll 1
    for (int rep = 0; rep < (PROBE_SUB == 2 ? 2 : 1); ++rep)
#pragma unroll 1
        for (int id = F.vcu; id < 256; id += F.G) lru_unit(F, l, id >> 6, (id >> 2) & 15, id & 3, id);
#pragma unroll 1
    for (int rep = 0; rep < (PROBE_SUB == 3 ? 2 : 1); ++rep) {
#pragma unroll 1
        for (int id = F.vcu; id < 256; id += F.G) lru_sample_unit(F, l, id >> 6, (id >> 2) & 15, id & 3);
        if (F.wave < 3) { for (int task = F.vcu * 3 + F.wave; task < 768; task += F.G * 3) attn_sample_task(F, l, task); }
        else kvcopy_range(F, l * KVC_LQ, l * KVC_LQ + KVC_LAYER, (F.vcu * 5 + (F.wave - 3)) * 64 + F.lane, F.G * 320);
        __syncthreads();
    }
}
typedef float f32x16 __attribute__((ext_vector_type(16)));
typedef float f32x2v __attribute__((ext_vector_type(2)));
template <int K, int LD, int NB, class Epi>
__device__ __forceinline__ void thin_gemm(const Frame& F, const bf16* A, const bf16* Bt, int N, const Epi& E) {
    int tid_ = F.tid; asm volatile("" : "+v"(tid_));
    const int tid = tid_, lane = tid & 63, wave = F.wave, r32 = lane & 31, hh = lane >> 5;
    constexpr int KS = K / 8, CH = 32, NCH = KS / CH, ROWS = 32 * (NB + 1), NI = ROWS / 16, BUFB = ROWS * 64, NBUF = (16384 / BUFB) < NCH ? (16384 / BUFB) : NCH;
    static_assert(NBUF >= 2 && NBUF * BUFB <= 16384 && NCH * CH == KS, "thin_gemm staging");
    __builtin_amdgcn_s_waitcnt(0x0F70);
    LAS float* part = (LAS float*)F.lds;
    LAS unsigned char* stg = F.lds + wave * 16384;
    const int rr = lane >> 2, sc = (lane & 3) ^ ((rr >> 1) & 3);
    const int rd = (r32 >> 4) * 1024 + (r32 & 15) * 64, rx = ((r32 & 15) >> 1) & 3;
#pragma unroll 1
    for (int item = F.vcu; item < N / (32 * NB); item += F.G) {
        const int n0 = item * 32 * NB;
        const GAS bf16* gw = (const GAS bf16*)Bt + (size_t)(n0 + rr) * LD + wave * KS + sc * 8;
        const GAS bf16* ga = (const GAS bf16*)A + (size_t)rr * LD + wave * KS + sc * 8;
        f32x16 acc[NB];
#pragma unroll
        for (int b = 0; b < NB; ++b)
#pragma unroll
            for (int i = 0; i < 16; ++i) acc[b][i] = 0.f;
#define THIN_STAGE(ch_) do { _Pragma("unroll") for (int j_ = 0; j_ < NI; ++j_) { \
            const GAS bf16* src_ = j_ < 2 * NB ? gw + (size_t)(16 * j_) * LD + (ch_) * CH : ga + (size_t)(16 * (j_ - 2 * NB)) * LD + (ch_) * CH; \
            __builtin_amdgcn_global_load_lds((const GAS unsigned*)src_, (LAS unsigned*)(stg + ((ch_) % NBUF) * BUFB + j_ * 1024), 16, 0, 0); } } while (0)
#pragma unroll
        for (int c = 0; c < NBUF - 1; ++c) THIN_STAGE(c);
#pragma unroll
        for (int ch = 0; ch < NCH; ++ch) {
            if (ch + NBUF - 1 < NCH) THIN_STAGE(ch + NBUF - 1);
            { constexpr int dummy = 0; (void)dummy; }
            const int ahead = (NCH - 1 - ch) < (NBUF - 1) ? (NCH - 1 - ch) : (NBUF - 1);
            if (ahead == 3) asm volatile("s_waitcnt vmcnt(%0)" :: "n"(3 * NI) : "memory");
            else if (ahead == 2) asm volatile("s_waitcnt vmcnt(%0)" :: "n"(2 * NI) : "memory");
            else if (ahead == 1) asm volatile("s_waitcnt vmcnt(%0)" :: "n"(NI) : "memory");
            else asm volatile("s_waitcnt vmcnt(0)" ::: "memory");
            const LAS unsigned char* bufp = stg + (ch % NBUF) * BUFB + rd;
            bf16x8 af[2], bf[NB][2];
#pragma unroll
            for (int ks = 0; ks < 2; ++ks) {
                const int po = ((2 * ks + hh) ^ rx) * 16;
                af[ks] = *(const LAS bf16x8*)(bufp + NB * 2048 + po);
#pragma unroll
                for (int b = 0; b < NB; ++b) bf[b][ks] = *(const LAS bf16x8*)(bufp + b * 2048 + po);
            }
            __builtin_amdgcn_sched_barrier(0);
#pragma unroll
            for (int ks = 0; ks < 2; ++ks)
#pragma unroll
                for (int b = 0; b < NB; ++b) acc[b] = __builtin_amdgcn_mfma_f32_32x32x16_bf16(af[ks], bf[b][ks], acc[b], 0, 0, 0);
            asm volatile("s_waitcnt lgkmcnt(0)" ::: "memory");
        }
#undef THIN_STAGE
        __syncthreads();
#pragma unroll
        for (int b = 0; b < NB; ++b)
#pragma unroll
            for (int reg = 0; reg < 16; ++reg) part[((wave * NB + b) * 32 + (reg & 3) + 8 * (reg >> 2) + 4 * hh) * 32 + r32] = acc[b][reg];
        __syncthreads();
        const int row = tid >> 4, c2 = (tid & 15) * 2;
#pragma unroll
        for (int b = 0; b < NB; ++b) {
            float v0 = 0.f, v1 = 0.f;
#pragma unroll
            for (int w = 0; w < 8; ++w) { const f32x2v pv = *(const LAS f32x2v*)(part + ((w * NB + b) * 32 + row) * 32 + c2); v0 += pv[0]; v1 += pv[1]; }
            E(row, n0 + b * 32 + c2, v0, v1);
        }
        __syncthreads();
    }
}
template <int K, int LD, int NB, class Epi>
__device__ __forceinline__ void thin_gemm_l(const Frame& F, const bf16* A, const bf16* Bt, int N, const Epi& E) {
    int tid_ = F.tid; asm volatile("" : "+v"(tid_));
    const int tid = tid_, lane = tid & 63, wave = F.wave, r32 = lane & 31, hh = lane >> 5;
    constexpr int KS = K / 8, CH = 64, NCH = KS / CH, NQ = NB * NCH, NI = 8, BUFB = 8192;
    static_assert(NCH * CH == KS && NQ >= 2, "thin_gemm_l staging");
    __builtin_amdgcn_s_waitcnt(0x0F70);
    LAS float* part = (LAS float*)F.lds;
    LAS unsigned char* stg = F.lds + wave * 16384;
    const int rr = lane >> 3, sc = (lane & 7) ^ rr;
    const int rd = (r32 >> 3) * 1024 + (r32 & 7) * 128, rx = r32 & 7;
#pragma unroll 1
    for (int item = F.vcu; item < N / (32 * NB); item += F.G) {
        const int n0 = item * 32 * NB;
        const GAS bf16* gw = (const GAS bf16*)Bt + (size_t)(n0 + rr) * LD + wave * KS + sc * 8;
        const GAS bf16* ga = (const GAS bf16*)A + (size_t)rr * LD + wave * KS + sc * 8;
        f32x16 acc[NB];
#pragma unroll
        for (int b = 0; b < NB; ++b)
#pragma unroll
            for (int i = 0; i < 16; ++i) acc[b][i] = 0.f;
#define THINL_STAGE(q_) do { _Pragma("unroll") for (int j_ = 0; j_ < NI; ++j_) { \
            const GAS bf16* src_ = j_ < 4 ? gw + (size_t)(32 * ((q_) / NCH) + 8 * j_) * LD + ((q_) % NCH) * CH : ga + (size_t)(8 * (j_ - 4)) * LD + ((q_) % NCH) * CH; \
            __builtin_amdgcn_global_load_lds((const GAS unsigned*)src_, (LAS unsigned*)(stg + ((q_) & 1) * BUFB + j_ * 1024), 16, 0, 0); } } while (0)
        THINL_STAGE(0);
#pragma unroll
        for (int q = 0; q < NQ; ++q) {
            if (q + 1 < NQ) { THINL_STAGE(q + 1); asm volatile("s_waitcnt vmcnt(%0)" :: "n"(NI) : "memory"); }
            else asm volatile("s_waitcnt vmcnt(0)" ::: "memory");
            const LAS unsigned char* bufp = stg + (q & 1) * BUFB + rd;
            bf16x8 af[4], bf[4];
#pragma unroll
            for (int ks = 0; ks < 4; ++ks) { const int po = ((2 * ks + hh) ^ rx) * 16; af[ks] = *(const LAS bf16x8*)(bufp + 4096 + po); bf[ks] = *(const LAS bf16x8*)(bufp + po); }
            __builtin_amdgcn_sched_barrier(0);
#pragma unroll
            for (int ks = 0; ks < 4; ++ks) acc[q / NCH] = __builtin_amdgcn_mfma_f32_32x32x16_bf16(af[ks], bf[ks], acc[q / NCH], 0, 0, 0);
            asm volatile("s_waitcnt lgkmcnt(0)" ::: "memory");
        }
#undef THINL_STAGE
        __syncthreads();
#pragma unroll
        for (int b = 0; b < NB; ++b)
#pragma unroll
            for (int reg = 0; reg < 16; ++reg) part[((wave * NB + b) * 32 + (reg & 3) + 8 * (reg >> 2) + 4 * hh) * 32 + r32] = acc[b][reg];
        __syncthreads();
        const int row = tid >> 4, c2 = (tid & 15) * 2;
#pragma unroll
        for (int b = 0; b < NB; ++b) {
            float v0 = 0.f, v1 = 0.f;
#pragma unroll
            for (int w = 0; w < 8; ++w) { const f32x2v pv = *(const LAS f32x2v*)(part + ((w * NB + b) * 32 + row) * 32 + c2); v0 += pv[0]; v1 += pv[1]; }
            E(row, n0 + b * 32 + c2, v0, v1);
        }
        __syncthreads();
    }
}
template <int K0, int K1, int LD, class Epi>
__device__ __forceinline__ void thin_gemm_pair(const Frame& F, const bf16* A0, const bf16* Bt0, const bf16* A1, const bf16* Bt1, int N, const Epi& E) {
    int tid_ = F.tid; asm volatile("" : "+v"(tid_));
    const int tid = tid_, lane = tid & 63, wave = F.wave, r32 = lane & 31, hh = lane >> 5;
    constexpr int KS0 = K0 / 8, KS1 = K1 / 8, CH = 32, NCH0 = KS0 / CH, NCH = NCH0 + KS1 / CH, NI = 4, BUFB = 64 * 64, NBUF = 4;
    static_assert(NBUF * BUFB <= 16384 && NCH0 * CH == KS0 && (NCH - NCH0) * CH == KS1 && NCH >= NBUF, "thin_gemm_pair staging");
    __builtin_amdgcn_s_waitcnt(0x0F70);
    LAS float* part = (LAS float*)F.lds;
    LAS unsigned char* stg = F.lds + wave * 16384;
    const int rr = lane >> 2, sc = (lane & 3) ^ ((rr >> 1) & 3);
    const int rd = (r32 >> 4) * 1024 + (r32 & 15) * 64, rx = ((r32 & 15) >> 1) & 3;
#pragma unroll 1
    for (int item = F.vcu; item < N / 32; item += F.G) {
        const int n0 = item * 32;
        const GAS bf16* gw0 = (const GAS bf16*)Bt0 + (size_t)(n0 + rr) * LD + wave * KS0 + sc * 8;
        const GAS bf16* ga0 = (const GAS bf16*)A0 + (size_t)rr * LD + wave * KS0 + sc * 8;
        const GAS bf16* gw1 = (const GAS bf16*)Bt1 + (size_t)(n0 + rr) * LD + wave * KS1 + sc * 8;
        const GAS bf16* ga1 = (const GAS bf16*)A1 + (size_t)rr * LD + wave * KS1 + sc * 8;
        f32x16 acc[2];
#pragma unroll
        for (int b = 0; b < 2; ++b)
#pragma unroll
            for (int i = 0; i < 16; ++i) acc[b][i] = 0.f;
#define THIN_STAGE2(ch_) do { _Pragma("unroll") for (int j_ = 0; j_ < NI; ++j_) { \
            const GAS bf16* w_ = (ch_) < NCH0 ? gw0 + (ch_) * CH : gw1 + ((ch_) - NCH0) * CH; const GAS bf16* a_ = (ch_) < NCH0 ? ga0 + (ch_) * CH : ga1 + ((ch_) - NCH0) * CH; \
            const GAS bf16* src_ = j_ < 2 ? w_ + (size_t)(16 * j_) * LD : a_ + (size_t)(16 * (j_ - 2)) * LD; \
            __builtin_amdgcn_global_load_lds((const GAS unsigned*)src_, (LAS unsigned*)(stg + ((ch_) % NBUF) * BUFB + j_ * 1024), 16, 0, 0); } } while (0)
#pragma unroll
        for (int c = 0; c < NBUF - 1; ++c) THIN_STAGE2(c);
#pragma unroll
        for (int ch = 0; ch < NCH; ++ch) {
            if (ch + NBUF - 1 < NCH) THIN_STAGE2(ch + NBUF - 1);
            const int ahead = (NCH - 1 - ch) < (NBUF - 1) ? (NCH - 1 - ch) : (NBUF - 1);
            if (ahead == 3) asm volatile("s_waitcnt vmcnt(%0)" :: "n"(3 * NI) : "memory");
            else if (ahead == 2) asm volatile("s_waitcnt vmcnt(%0)" :: "n"(2 * NI) : "memory");
            else if (ahead == 1) asm volatile("s_waitcnt vmcnt(%0)" :: "n"(NI) : "memory");
            else asm volatile("s_waitcnt vmcnt(0)" ::: "memory");
            const LAS unsigned char* bufp = stg + (ch % NBUF) * BUFB + rd;
            bf16x8 af[2], bf[2];
#pragma unroll
            for (int ks = 0; ks < 2; ++ks) { const int po = ((2 * ks + hh) ^ rx) * 16; af[ks] = *(const LAS bf16x8*)(bufp + 2048 + po); bf[ks] = *(const LAS bf16x8*)(bufp + po); }
            __builtin_amdgcn_sched_barrier(0);
#pragma unroll
            for (int ks = 0; ks < 2; ++ks) acc[ch < NCH0 ? 0 : 1] = __builtin_amdgcn_mfma_f32_32x32x16_bf16(af[ks], bf[ks], acc[ch < NCH0 ? 0 : 1], 0, 0, 0);
            asm volatile("s_waitcnt lgkmcnt(0)" ::: "memory");
        }
#undef THIN_STAGE2
        __syncthreads();
#pragma unroll
        for (int b = 0; b < 2; ++b)
#pragma unroll
            for (int reg = 0; reg < 16; ++reg) part[((wave * 2 + b) * 32 + (reg & 3) + 8 * (reg >> 2) + 4 * hh) * 32 + r32] = acc[b][reg];
        __syncthreads();
        const int row = tid >> 4, c2 = (tid & 15) * 2;
        float v[2][2] = {{0.f, 0.f}, {0.f, 0.f}};
#pragma unroll
        for (int b = 0; b < 2; ++b)
#pragma unroll
            for (int w = 0; w < 8; ++w) { const f32x2v pv = *(const LAS f32x2v*)(part + ((w * 2 + b) * 32 + row) * 32 + c2); v[b][0] += pv[0]; v[b][1] += pv[1]; }
        E(row, n0 + c2, v[0][0], v[0][1], v[1][0], v[1][1]);
        __syncthreads();
    }
}
struct ThinIn {
    bf16 *Q, *K, *V, *ZA, *XL, *ZL, *GA, *GL; GAS float* out; int l;
    __device__ __forceinline__ void operator()(int r, int c, float v0, float v1) const {
        const size_t row = MP + r; const int bs = r >> 2, s = r & 3;
        if (c < C_K) { *(unsigned*)(Q + row * QKVW + c) = pk2(v0 * QSCALE, v1 * QSCALE); }
        else if (c < C_ZA) {
            const int which = c < C_V ? 1 : 2, cc = c - which * QKVW, gi = cc >> 10, Wg = gi == 0 ? 128 : (gi == 1 ? 512 : 2048);
            *(unsigned*)((which == 1 ? K : V) + row * QKVW + cc) = pk2(v0, v1);
            GAS float* dst = out + (gi == 0 ? O_KVS0 : (gi == 1 ? O_KVS1 : O_KVS2)) + (((size_t)(l * NB_S + bs) * Wg + (Wg - 4 + s)) * 2 + (which - 1)) * 1024 + (cc & 1023);
            dst[0] = v0; dst[1] = v1;
        }
        else if (c < C_XL) { *(unsigned*)(ZA + row * ATTW + (c - C_ZA)) = pk2(v0, v1); }
        else if (c < C_ZL) {
            *(unsigned*)(XL + row * DM + (c - C_XL)) = pk2(v0, v1);
            if (s >= 1) { GAS float* dst = out + O_CVS + ((size_t)(l * NB_S + bs) * 3 + (s - 1)) * DM + (c - C_XL); dst[0] = v0; dst[1] = v1; }
        }
        else if (c < C_GA) { *(unsigned*)(ZL + row * DM + (c - C_ZL)) = pk2(v0 * sigm(v0), v1 * sigm(v1)); }
        else if (c < C_GL) { *(unsigned*)(GA + row * DM + (c - C_GA)) = pk2(sigm(v0), sigm(v1)); }
        else { *(unsigned*)(GL + row * DM + (c - C_GL)) = pk2(sigm(v0), sigm(v1)); }
    }
};
struct ThinPA { const bf16* GA; bf16* TMP;
    __device__ __forceinline__ void operator()(int r, int c, float v0, float v1) const { const size_t o = (size_t)(MP + r) * DM + c; const unsigned g = *(const unsigned*)(GA + o); *(unsigned*)(TMP + o) = pk2(v0 * bflo(g), v1 * bfhi(g)); } };
struct ThinPB { const bf16* GL; const bf16* TMP; bf16* MG;
    __device__ __forceinline__ void operator()(int r, int c, float v0, float v1) const { const size_t o = (size_t)(MP + r) * DM + c; const unsigned g = *(const unsigned*)(GL + o), tw = *(const unsigned*)(TMP + o); *(unsigned*)(MG + o) = pk2(bflo(tw) + v0 * bflo(g), bfhi(tw) + v1 * bfhi(g)); } };
struct ThinPAB { const bf16* GA; const bf16* GL; bf16* MG;
    __device__ __forceinline__ void operator()(int r, int c, float a0, float a1, float l0, float l1) const { const size_t o = (size_t)(MP + r) * DM + c; const unsigned ga = *(const unsigned*)(GA + o), gl = *(const unsigned*)(GL + o);
        *(unsigned*)(MG + o) = pk2(a0 * bflo(ga) + l0 * bflo(gl), a1 * bfhi(ga) + l1 * bfhi(gl)); } };
struct ThinOut { const float* xs; float* X; const float* mod; int l;
    __device__ __forceinline__ void operator()(int r, int c, float v0, float v1) const {
        const size_t o = (size_t)(MP + r) * DM + c; const float* gp = mod + (size_t)(l * NMODB + NB_P + (r >> 2)) * 6144 + 4096 + c;
        const float x0 = l == 0 ? xs[(size_t)r * DM + c] : X[o], x1 = l == 0 ? xs[(size_t)r * DM + c + 1] : X[o + 1];
        X[o] = x0 + gp[0] * v0; X[o + 1] = x1 + gp[1] * v1; } };
struct MergeRow { float l0, l1, l2; u32x4 a[2], b[2], c[2], z[2]; };
__device__ __forceinline__ void merge_load(const Frame& F, int r, int lane, MergeRow& m) {
    const bf16* OG = (const bf16*)(F.ws + WS_OG); const float* LSE = (const float*)(F.ws + WS_LSE); const bf16* ZA = (const bf16*)(F.ws + WS_ZA);
    const int h = lane >> 3;
    m.l0 = LSE[((size_t)0 * MPAD + r) * 8 + h]; m.l1 = LSE[((size_t)1 * MPAD + r) * 8 + h]; m.l2 = LSE[((size_t)2 * MPAD + r) * 8 + h];
#pragma unroll
    for (int hf = 0; hf < 2; ++hf) {
        const size_t co = (size_t)r * ATTW + lane * 16 + hf * 8;
        m.a[hf] = *(const u32x4*)(OG + co); m.b[hf] = *(const u32x4*)(OG + (size_t)MPAD * ATTW + co); m.c[hf] = *(const u32x4*)(OG + (size_t)2 * MPAD * ATTW + co); m.z[hf] = *(const u32x4*)(ZA + co);
    }
}
__device__ __forceinline__ void merge_store(const Frame& F, int r, int lane, const MergeRow& m) {
    bf16* AA = (bf16*)(F.ws + WS_AA);
    const float mx = fmaxf(m.l0, fmaxf(m.l1, m.l2));
    float w0 = __builtin_amdgcn_exp2f(m.l0 - mx), w1 = __builtin_amdgcn_exp2f(m.l1 - mx), w2 = __builtin_amdgcn_exp2f(m.l2 - mx);
    const float inv = __builtin_amdgcn_rcpf(w0 + w1 + w2); w0 *= inv; w1 *= inv; w2 *= inv;
#pragma unroll
    for (int hf = 0; hf < 2; ++hf) {
        u32x4 o;
#pragma unroll
        for (int e = 0; e < 4; ++e) {
            const float zl = bflo(m.z[hf][e]), zh = bfhi(m.z[hf][e]);
            const float lo = (w0 * bflo(m.a[hf][e]) + w1 * bflo(m.b[hf][e]) + w2 * bflo(m.c[hf][e])) * (zl * sigm(zl));
            const float hi = (w0 * bfhi(m.a[hf][e]) + w1 * bfhi(m.b[hf][e]) + w2 * bfhi(m.c[hf][e])) * (zh * sigm(zh));
            o[e] = pk2(lo, hi);
        }
        *(u32x4*)(AA + (size_t)r * DM + lane * 16 + hf * 8) = o;
    }
}
__device__ __forceinline__ void phase_merge(const Frame& F) {
    const int gw = F.vcu * 8 + F.wave, NGW = F.G * 8, lane = F.lane;
#pragma unroll 1
    for (int r0 = 4 * gw; r0 < MR; r0 += 4 * NGW) {
        const int nrow = (MR - r0) < 4 ? (MR - r0) : 4;
        MergeRow cur, nxt;
        merge_load(F, r0, lane, cur);
#pragma unroll
        for (int k = 0; k < 4; ++k) if (k < nrow) {
            if (k + 1 < nrow) merge_load(F, r0 + k + 1, lane, nxt);
            merge_store(F, r0 + k, lane, cur);
            cur = nxt;
        }
    }
}

#ifndef MK_PER_PHASE
#define MK_PER_PHASE 0
#endif
constexpr int N_PHASES = 2 + 6 * DEPTH + 1;

__global__ void __launch_bounds__(512, 2) fwd_kernel(Args args) {
    extern __shared__ __attribute__((aligned(16))) unsigned char lds_raw[];
    Frame F0;
    F0.lds = (LAS unsigned char*)lds_raw;
    F0.tid = threadIdx.x; F0.lane = F0.tid & 63; F0.wave = __builtin_amdgcn_readfirstlane(F0.tid >> 6);
    F0.G = gridDim.x; { const int bx = blockIdx.x; F0.vcu = (F0.G % 8 == 0) ? (bx % 8) * (F0.G / 8) + bx / 8 : bx; }
    F0.out = (GAS float*)args.out; F0.ws = (GAS unsigned char*)args.ws;
    for (int u = F0.tid; u < 128; u += 512) ((LAS unsigned*)(F0.lds + LDSCTL_OFF))[u] = 0u;
    __syncthreads();
    unsigned* ctl = (unsigned*)(args.ws + WS_CTL);
    XcdBarrier bar = xcd_barrier_post(ctl + CW_BAR + args.li * XCD_BAR_WORDS, (volatile LAS unsigned*)(F0.lds + LDSCTL_OFF) + 8);
    const int lo = args.ph_lo, hi = args.ph_hi;
#define IN(k) (lo <= (k) && (k) < hi)
#define IS_T0() (F0.wave == 0 && hw_lane() == 0)
#ifndef PROBE_XBAR
#define PROBE_XBAR 1
#endif
#ifdef TPROBE
#define SEAM(k) do { if (IN(k) && IN((k) + 1)) { const unsigned ts0_ = (unsigned)__builtin_amdgcn_s_memrealtime(); xcd_barrier(bar, IS_T0()); const unsigned ts1_ = (unsigned)__builtin_amdgcn_s_memrealtime(); \
        if (F0.tid == 0) { __hip_atomic_fetch_add((LAS unsigned*)(F0.lds + LDSCTL_OFF) + 104, ts1_ - ts0_, __ATOMIC_RELAXED, __HIP_MEMORY_SCOPE_WORKGROUP); \
            if ((k) == TPROBE_SEAM || (TPROBE_SEAM >= 100 && (k) >= 2 && ((k) - 2) % 6 == TPROBE_SEAM - 100)) __hip_atomic_fetch_add((LAS unsigned*)(F0.lds + LDSCTL_OFF) + 105, ts1_ - ts0_, __ATOMIC_RELAXED, __HIP_MEMORY_SCOPE_WORKGROUP); } } } while (0)
#else
#define SEAM(k) do { if (IN(k) && IN((k) + 1)) { for (int xb_ = 0; xb_ < PROBE_XBAR; ++xb_) xcd_barrier(bar, IS_T0()); } } while (0)
#endif
#ifndef PROBE_REP
#define PROBE_REP (-1)
#endif
#ifndef PROBE_N
#define PROBE_N 1
#endif
#ifdef TPROBE
#ifndef TPROBE_SEAM
#define TPROBE_SEAM (-1)
#endif
#define TP_BEGIN() const unsigned tq0_ = (unsigned)__builtin_amdgcn_s_memrealtime()
#define TP_END(w) do { const unsigned tq1_ = (unsigned)__builtin_amdgcn_s_memrealtime(); if (F.tid == 0) __hip_atomic_fetch_add((LAS unsigned*)(F.lds + LDSCTL_OFF) + (w), tq1_ - tq0_, __ATOMIC_RELAXED, __HIP_MEMORY_SCOPE_WORKGROUP); } while (0)
#define TP_BEGIN2() const unsigned tr0_ = (unsigned)__builtin_amdgcn_s_memrealtime()
#define TP_END2(w) do { const unsigned tr1_ = (unsigned)__builtin_amdgcn_s_memrealtime(); if (F.tid == 0) __hip_atomic_fetch_add((LAS unsigned*)(F.lds + LDSCTL_OFF) + (w), tr1_ - tr0_, __ATOMIC_RELAXED, __HIP_MEMORY_SCOPE_WORKGROUP); } while (0)
#else
#define TP_BEGIN2() do {} while (0)
#define TP_END2(w) do {} while (0)
#define TP_BEGIN() do {} while (0)
#define TP_END(w) do {} while (0)
#endif
#define REPEAT(kind, ...) do { __VA_ARGS__ if (PROBE_REP == (kind)) { for (int rep_ = 0; rep_ < PROBE_N; ++rep_) { xcd_barrier(bar, IS_T0()); __VA_ARGS__ } } } while (0)

    #ifndef NO_P0
    if (IN(0)) REPEAT(0, { const Frame F = fresh(F0); p0_prologue(F); });
#endif
    SEAM(0);
    #ifndef NO_P1
    if (IN(1)) { const Frame F = fresh(F0); p1_modreduce(F); }
#endif
    SEAM(1);
#pragma unroll 1
    for (int l = 0; l < DEPTH; ++l) {
        const int pb = 2 + 6 * l;
#ifndef NO_PA
        if (IN(pb)) REPEAT(2, { const Frame F = fresh(F0); phase_norm(F, l); });
#endif
        SEAM(pb);
#if PROBE_REP == 7
        if (IN(pb + 1)) for (int rep_ = 0; rep_ < PROBE_N; ++rep_) {
            const Frame F = fresh(F0);
            pg8::Gemm g{(const pg8::bf16_t*)(F.ws + WS_H), (const pg8::bf16_t*)(F.ws + WS_WIN) + (size_t)l * INC * DM, MP, INC, DM};
            pg8::StaticOrder S; S.init(MP, INC, F.G, (int)blockIdx.x);
            EpiNull<true> E;
            pg8::gemm_phase<EpiNull<true>, pg8::StaticOrder, true, true>(F.lds, g, S, E, F.tid);
            xcd_barrier(bar, IS_T0());
        }
#endif
#if PROBE_REP == 8
        if (IN(pb + 1)) for (int rep_ = 0; rep_ < PROBE_N; ++rep_) {
            const Frame F = fresh(F0);
            pg8::Gemm g{(const pg8::bf16_t*)(F.ws + WS_H), (const pg8::bf16_t*)(F.ws + WS_WOUT) + (size_t)l * DM * DM, MP, DM, DM};
            pg8::StaticOrder S; S.init(MP, DM, F.G, (int)blockIdx.x);
            EpiNull<false> E;
            pg8::gemm_phase<EpiNull<false>, pg8::StaticOrder, false, true>(F.lds, g, S, E, F.tid);
            xcd_barrier(bar, IS_T0());
        }
#endif
#if PROBE_REP == 9
        if (IN(pb + 1)) for (int rep_ = 0; rep_ < PROBE_N; ++rep_) {
            const Frame F = fresh(F0);
            pg8::Gemm g0{(const pg8::bf16_t*)(F.ws + WS_H), (const pg8::bf16_t*)(F.ws + WS_WPA) + (size_t)l * DM * DM, MP, DM, ATTW};
            pg8::Gemm g1{(const pg8::bf16_t*)(F.ws + WS_H), (const pg8::bf16_t*)(F.ws + WS_WPB) + (size_t)l * DM * DM, MP, DM, DM};
            pg8::StaticOrder S; S.init(MP, DM, F.G, (int)blockIdx.x);
            EpiNull<true> E;
            pg8::gemm_chain<EpiNull<true>, pg8::StaticOrder>(F.lds, g0, g1, DM, S, E, F.tid);
            xcd_barrier(bar, IS_T0());
        }
#endif
#ifndef NO_PB
        if (IN(pb + 1)) REPEAT(3, {
            const Frame F = fresh(F0);
            pg8::Gemm g{(const pg8::bf16_t*)(F.ws + WS_H), (const pg8::bf16_t*)(F.ws + WS_WIN) + (size_t)l * INC * DM, MP, INC, DM};
            pg8::StaticOrder S; S.init(MP, INC, F.G, (int)blockIdx.x);
            EpiIn E{(bf16*)(F.ws + WS_Q), (bf16*)(F.ws + WS_K), (bf16*)(F.ws + WS_V), (bf16*)(F.ws + WS_ZA), (bf16*)(F.ws + WS_XL), (bf16*)(F.ws + WS_ZL), (bf16*)(F.ws + WS_GA), (bf16*)(F.ws + WS_GL), F.out, l};
#ifdef STAG_G
            { const int sg = ((int)blockIdx.x >> 3) & (STAG_G - 1);
              if (sg) { const long long t0 = wall_clock64(); while (wall_clock64() - t0 < (long long)sg * STAG_TICKS) __builtin_amdgcn_s_sleep(8); } }
#endif
            TP_BEGIN();
            pg8::gemm_phase<EpiIn, pg8::StaticOrder, true, true>(F.lds, g, S, E, F.tid);
            TP_END(101);
            ThinIn TE{E.Q, E.K, E.V, E.ZA, E.XL, E.ZL, E.GA, E.GL, F.out, l};
            TP_BEGIN2();
            thin_gemm_l<DM, DM, 3, ThinIn>(F, (const bf16*)(F.ws + WS_H) + (size_t)MP * DM, (const bf16*)(F.ws + WS_WIN) + (size_t)l * INC * DM, INC, TE);
            TP_END2(102);
        });
#endif
        SEAM(pb + 1);
#ifndef NO_PC
        if (IN(pb + 2)) REPEAT(4, { const Frame F = fresh(F0); phase_mix(F, l); });
#endif
        SEAM(pb + 2);
#ifndef NO_PC2
        if (IN(pb + 3)) REPEAT(5, { const Frame F = fresh(F0); phase_merge(F); });
#endif
        SEAM(pb + 3);
#ifndef NO_PD
        if (IN(pb + 4)) REPEAT(6, {
            const Frame F = fresh(F0);
            {
                pg8::Gemm g0{(const pg8::bf16_t*)(F.ws + WS_AA), (const pg8::bf16_t*)(F.ws + WS_WPA) + (size_t)l * DM * DM, MP, DM, ATTW};
                pg8::Gemm g1{(const pg8::bf16_t*)(F.ws + WS_AL), (const pg8::bf16_t*)(F.ws + WS_WPB) + (size_t)l * DM * DM, MP, DM, DM};
                pg8::StaticOrder S; S.init(MP, DM, F.G, (int)blockIdx.x);
                EpiMerge E{(const bf16*)(F.ws + WS_GA), (const bf16*)(F.ws + WS_GL), (bf16*)(F.ws + WS_MG)};
                pg8::gemm_chain<EpiMerge, pg8::StaticOrder>(F.lds, g0, g1, DM, S, E, F.tid);
            }
            {
                TP_BEGIN2();
                ThinPAB TE{(const bf16*)(F.ws + WS_GA), (const bf16*)(F.ws + WS_GL), (bf16*)(F.ws + WS_MG)};
                thin_gemm_pair<ATTW, DM, DM, ThinPAB>(F, (const bf16*)(F.ws + WS_AA) + (size_t)MP * DM, (const bf16*)(F.ws + WS_WPA) + (size_t)l * DM * DM,
                                                      (const bf16*)(F.ws + WS_AL) + (size_t)MP * DM, (const bf16*)(F.ws + WS_WPB) + (size_t)l * DM * DM, DM, TE);
                TP_END2(103);
            }
        });
#endif
        SEAM(pb + 4);
#ifndef NO_PE
        if (IN(pb + 5)) {
            const Frame F = fresh(F0);
            pg8::Gemm g{(const pg8::bf16_t*)(F.ws + WS_MG), (const pg8::bf16_t*)(F.ws + WS_WOUT) + (size_t)l * DM * DM, MP, DM, DM};
            pg8::StaticOrder S; S.init(MP, DM, F.G, (int)blockIdx.x);
            const KArgs A = kargs();
            EpiOut E{KIN(A, XP), KIN(A, XS), (float*)(F.ws + WS_X), (const float*)(F.ws + WS_MOD), l};
            pg8::gemm_phase<EpiOut, pg8::StaticOrder, false, true>(F.lds, g, S, E, F.tid);
            ThinOut TE{E.xs, E.X, E.mod, l};
            TP_BEGIN2();
            thin_gemm<DM, DM, 1, ThinOut>(F, (const bf16*)(F.ws + WS_MG) + (size_t)MP * DM, (const bf16*)(F.ws + WS_WOUT) + (size_t)l * DM * DM, DM, TE);
            TP_END2(103);
        }
#endif
        SEAM(pb + 5);
    }
#ifndef NO_PF
    { int lo2 = lo, hi2 = hi; asm volatile("" : "+s"(lo2), "+s"(hi2));
      if (lo2 <= N_PHASES - 1 && N_PHASES - 1 < hi2) { const Frame F = fresh(F0); phase_final(F); } }
#endif
#ifdef TPROBE
    {
        __syncthreads();
#ifndef TPROBE_SEAM
#define TPROBE_SEAM (-1)
#endif
#ifndef TPROBE_C
#define TPROBE_C 0
#endif
        const unsigned raw = ((volatile LAS unsigned*)(F0.lds + LDSCTL_OFF))[99 + TPROBE];
        const unsigned sel = TPROBE == 0 ? 50000u : (TPROBE_C > 0 ? (raw < (unsigned)TPROBE_C ? (unsigned)TPROBE_C - raw : 0u) : raw) * TPROBE_MUL;
        const unsigned t0 = (unsigned)__builtin_amdgcn_s_memrealtime();
        while ((unsigned)__builtin_amdgcn_s_memrealtime() - t0 < sel) __builtin_amdgcn_s_sleep(16);
    }
#endif
#undef IN
#undef SEAM
}

extern "C" void kernel_launch(void* const* d_in, const int* in_sizes, int n_in, void* d_out, int out_size, void* d_ws, size_t ws_size, hipStream_t stream) {
    static int grid = 0;
    if (grid == 0) {
        if (n_in != 25 || (size_t)out_size != O_END || ws_size < WS_END) { fprintf(stderr, "kernel_launch: built for 25 inputs, %zu outputs, >= %zu bytes of workspace; got n_in %d, out %d, ws %zu; nothing launched\n", (size_t)O_END, (size_t)WS_END, n_in, out_size, ws_size); grid = -1; return; }
        int dev = 0, cus = 0, per_cu = 0;
        if (hipGetDevice(&dev) != hipSuccess || hipDeviceGetAttribute(&cus, hipDeviceAttributeMultiprocessorCount, dev) != hipSuccess) { fprintf(stderr, "kernel_launch: device query failed\n"); grid = -1; return; }
        if (hipFuncSetAttribute((const void*)fwd_kernel, hipFuncAttributeMaxDynamicSharedMemorySize, LDS_BYTES) != hipSuccess) { fprintf(stderr, "kernel_launch: hipFuncSetAttribute failed\n"); grid = -1; return; }
        if (hipOccupancyMaxActiveBlocksPerMultiprocessor(&per_cu, (const void*)fwd_kernel, 512, LDS_BYTES) != hipSuccess || per_cu < 1) fprintf(stderr, "kernel_launch: note: occupancy query reports %d workgroups per CU\n", per_cu);
        (void)hipGetLastError();
        grid = cus;
    }
    if (grid < 0) return;
    static_assert((size_t)(CW_BAR + XCD_BAR_WORDS) * 4 <= 64 * 1024 && CW_P0Q < CW_BAR, "control words of the one-launch build lie in the first 64 KiB");
    if (hipMemsetAsync((char*)d_ws + WS_CTL, 0, MK_PER_PHASE ? CTL_ZERO_BYTES : (size_t)64 * 1024, stream) != hipSuccess) { fprintf(stderr, "kernel_launch: hipMemsetAsync failed\n"); return; }
    Args a{};
    for (int i = 0; i < 25; ++i) a.in[i] = (const float*)d_in[i];
    a.out = (float*)d_out; a.ws = (unsigned char*)d_ws;
#if MK_PER_PHASE
    for (int p = 0; p < N_PHASES; ++p) { a.ph_lo = p; a.ph_hi = p + 1; a.li = p; a.pad = 0; hipLaunchKernelGGL(fwd_kernel, dim3(grid), dim3(512), LDS_BYTES, stream, a); }
#else
    a.ph_lo = 0; a.ph_hi = N_PHASES; a.li = 0; a.pad = 0;
    hipLaunchKernelGGL(fwd_kernel, dim3(grid), dim3(512), LDS_BYTES, stream, a);
#endif
    const hipError_t le = hipPeekAtLastError();
    if (le != hipSuccess) fprintf(stderr, "kernel_launch: launch failed: %s\n", hipGetErrorName(le));
}
```
